# Optimizing an MI355X kernel written in HIP

```python
import jax, jax.numpy as jnp
from jax import lax
import numpy as np

D_MODEL = 1024
BATCH = 16
SEQ = 4096
DEPTH = 2

N_EVEN = (DEPTH + 1) // 2
N_ODD = DEPTH // 2

HGRN_KDIM = 128
HGRN_WIDTH = D_MODEL // 2
HGRN_HEADS = HGRN_WIDTH // HGRN_KDIM
HGRN_VDIM = HGRN_WIDTH // HGRN_HEADS
HGRN_CHUNK = 64

FOX_HDIM = 64
FOX_WIDTH = D_MODEL // 2
FOX_HEADS = FOX_WIDTH // FOX_HDIM
FOX_BLOCK = 128

MIX_WIDTH = HGRN_WIDTH + FOX_WIDTH
AB_IN = 4 * HGRN_WIDTH + 4 * FOX_WIDTH + FOX_HEADS

RWKV_HDIM = 64
RWKV_HEADS = D_MODEL // RWKV_HDIM
DECAY_LORA = 64
AAA_LORA = 64
GATE_LORA = 128

D_FF = 4 * D_MODEL

RMS_EPS = 1e-6
GN_EPS = 64e-5

kernel_name = "hgrn2_fox_rwkv7_hybrid"


def rmsnorm(x, g, eps=RMS_EPS):
    xf = x.astype(jnp.float32)
    y = xf * lax.rsqrt(jnp.mean(xf * xf, axis=-1, keepdims=True) + eps)
    return (y * g.astype(jnp.float32)).astype(x.dtype)


def hgrn2_chunkwise(q, k, v, log_f):
    B, S, H, DK = q.shape
    DV = v.shape[-1]
    C = HGRN_CHUNK
    NC = S // C

    def to_chunks(t):
        return t.astype(jnp.float32).reshape(B, NC, C, H, t.shape[-1]).transpose(1, 0, 3, 2, 4)

    qc, kc, vc, gc = to_chunks(q), to_chunks(k), to_chunks(v), to_chunks(log_f)
    causal = jnp.tril(jnp.ones((C, C), dtype=bool))[:, :, None]

    def step(state, inp):
        qb, kb, vb, gb = inp
        b = jnp.cumsum(gb, axis=2)
        diff = b[:, :, :, None, :] - b[:, :, None, :, :]
        decay = jnp.exp(jnp.where(causal, diff, -jnp.inf))
        scores = jnp.einsum('bhtd,bhtsd,bhsd->bhts', qb, decay, kb)
        o = (jnp.einsum('bhts,bhsv->bhtv', scores, vb)
             + jnp.einsum('bhtd,bhdv->bhtv', qb * jnp.exp(b), state))
        b_last = b[:, :, -1:, :]
        state = (state * jnp.exp(b_last[:, :, 0, :])[..., None]
                 + jnp.einsum('bhsd,bhsv->bhdv', kb * jnp.exp(b_last - b), vb))
        return state, o

    s0 = jnp.zeros((B, H, DK, DV), jnp.float32)
    _, o = lax.scan(step, s0, (qc, kc, vc, gc))
    return o.transpose(1, 0, 3, 2, 4).reshape(B, S, H, DV)


def fox_attention(q, k, v, log_f):
    B, S, H, Dh = q.shape
    scale = Dh ** -0.5
    c = jnp.cumsum(log_f.astype(jnp.float32), axis=1).transpose(0, 2, 1)
    qh = q.transpose(0, 2, 1, 3)
    kh = k.transpose(0, 2, 1, 3)
    vh = v.transpose(0, 2, 1, 3)
    q_idx = jnp.arange(FOX_BLOCK)
    outs = []
    for i in range(S // FOX_BLOCK):
        q0 = i * FOX_BLOCK
        kv_len = q0 + FOX_BLOCK
        qb = qh[:, :, q0:kv_len]
        kb = kh[:, :, :kv_len]
        vb = vh[:, :, :kv_len]
        logits = (jnp.einsum('bhqd,bhkd->bhqk', qb, kb).astype(jnp.float32) * scale
                  + c[:, :, q0:kv_len, None] - c[:, :, None, :kv_len])
        mask = (q0 + q_idx)[:, None] >= jnp.arange(kv_len)[None, :]
        p = jax.nn.softmax(jnp.where(mask, logits, -jnp.inf), axis=-1)
        outs.append(jnp.einsum('bhqk,bhkd->bhqd', p.astype(vb.dtype), vb))
    return jnp.concatenate(outs, axis=2).transpose(0, 2, 1, 3)


def hgrn_fox_mixer(h, w_in, lb, hgrn_norm_g, fox_fb, fox_q_g, fox_k_g, w_out):
    B, S, _ = h.shape
    proj = h @ w_in
    sizes = [HGRN_WIDTH] * 4 + [FOX_WIDTH] * 4
    splits = np.cumsum(sizes).tolist()
    a_q, a_f, a_i, a_g, b_q, b_k, b_v, b_g, b_f = jnp.split(proj, splits, axis=-1)

    lbf = lb.astype(jnp.float32)
    f = lbf + (1.0 - lbf) * jax.nn.sigmoid(a_f.astype(jnp.float32))
    hd = (B, S, HGRN_HEADS, HGRN_KDIM)
    o_a = hgrn2_chunkwise(jax.nn.silu(a_q).reshape(hd), (1.0 - f).reshape(hd),
                          a_i.reshape(B, S, HGRN_HEADS, HGRN_VDIM), jnp.log(f).reshape(hd))
    o_a = rmsnorm(o_a, hgrn_norm_g.reshape(HGRN_HEADS, HGRN_VDIM))
    o_a = o_a * jax.nn.silu(a_g.astype(jnp.float32)).reshape(B, S, HGRN_HEADS, HGRN_VDIM)

    fd = (B, S, FOX_HEADS, FOX_HDIM)
    q = rmsnorm(b_q.reshape(fd), fox_q_g)
    k = rmsnorm(b_k.reshape(fd), fox_k_g)
    log_fg = jax.nn.log_sigmoid((b_f + fox_fb).astype(jnp.float32))
    o_b = fox_attention(q, k, b_v.reshape(fd), log_fg)
    o_b = o_b * jax.nn.sigmoid(b_g).reshape(fd)

    y = jnp.concatenate([o_a.reshape(B, S, HGRN_WIDTH).astype(h.dtype),
                         o_b.reshape(B, S, FOX_WIDTH).astype(h.dtype)], axis=-1)
    return y @ w_out


def wkv7_scan(r, w, k, v, a, b):
    B, S, H, N = r.shape

    def step(state, inp):
        r_t, w_t, k_t, v_t, a_t, b_t = inp
        sa = jnp.einsum('bhvk,bhk->bhv', state, a_t)
        state = (state * w_t[:, :, None, :] + sa[..., None] * b_t[:, :, None, :]
                 + v_t[..., None] * k_t[:, :, None, :])
        return state, jnp.einsum('bhvk,bhk->bhv', state, r_t)

    xs = tuple(t.astype(jnp.float32).transpose(1, 0, 2, 3) for t in (r, w, k, v, a, b))
    s0 = jnp.zeros((B, H, N, N), jnp.float32)
    _, y = lax.scan(step, s0, xs)
    return y.transpose(1, 0, 2, 3)


def rwkv7_mixer(h, mu, w_rkv, w0, w1, w2, a0, a1, a2, g1, g2, k_k, k_a, r_k, lnx_g, lnx_b, w_o):
    B, S, D = h.shape
    H, N = RWKV_HEADS, RWKV_HDIM
    xx = jnp.pad(h, ((0, 0), (1, 0), (0, 0)))[:, :-1] - h
    mixed = h[:, :, None, :] + xx[:, :, None, :] * mu
    xr, xw, xk, xv, xa, xg = [mixed[:, :, i] for i in range(6)]

    r = xr @ w_rkv[0]
    k = xk @ w_rkv[1]
    v = xv @ w_rkv[2]
    w_log = -jax.nn.softplus(-(w0 + jnp.tanh(xw @ w1) @ w2).astype(jnp.float32)) - 0.5
    decay = jnp.exp(-jnp.exp(w_log))
    a = jax.nn.sigmoid((a0 + (xa @ a1) @ a2).astype(jnp.float32))
    g = jax.nn.sigmoid(xg @ g1) @ g2

    hs = (B, S, H, N)
    kk = (k * k_k).astype(jnp.float32).reshape(hs)
    kk = kk * lax.rsqrt(jnp.maximum(jnp.sum(kk * kk, axis=-1, keepdims=True), 1e-24))
    k = k.astype(jnp.float32) * (1.0 + (a - 1.0) * k_a.astype(jnp.float32))
    r4, k4, v4 = r.astype(jnp.float32).reshape(hs), k.reshape(hs), v.astype(jnp.float32).reshape(hs)
    a4 = a.reshape(hs)

    y = wkv7_scan(r4, decay.reshape(hs), k4, v4, -kk, kk * a4)
    mean = jnp.mean(y, axis=-1, keepdims=True)
    var = jnp.mean(jnp.square(y - mean), axis=-1, keepdims=True)
    y = ((y - mean) * lax.rsqrt(var + GN_EPS)).reshape(B, S, D) * lnx_g + lnx_b
    bonus = jnp.sum(r4 * k4 * r_k.astype(jnp.float32), axis=-1, keepdims=True) * v4
    y = y + bonus.reshape(B, S, D)
    return (y * g).astype(h.dtype) @ w_o


def sqrelu_mlp(h, w_up, w_down):
    return jnp.square(jax.nn.relu(h @ w_up)) @ w_down


def setup_inputs(seed: int = 0) -> dict:
    key = jax.random.key(seed)
    ks = iter(jax.random.split(key, 40))
    D = D_MODEL

    def nrm(shape, scale):
        return jax.random.normal(next(ks), shape, jnp.float32) * scale

    def unif(shape, lo, hi):
        return jax.random.uniform(next(ks), shape, jnp.float32, lo, hi)

    return {
        "x": nrm((BATCH, SEQ, D), 1.0),
        "norm_mix_g": 1.0 + nrm((DEPTH, D), 0.02),
        "norm_ffn_g": 1.0 + nrm((DEPTH, D), 0.02),
        "ab_w_in": nrm((N_EVEN, D, AB_IN), D ** -0.5),
        "hgrn_lower_bounds": nrm((DEPTH + 1, HGRN_WIDTH), 0.1),
        "hgrn_norm_g": 1.0 + nrm((N_EVEN, HGRN_WIDTH), 0.02),
        "fox_forget_bias": 2.0 + nrm((N_EVEN, FOX_HEADS), 0.1),
        "fox_q_norm_g": 1.0 + nrm((N_EVEN, FOX_HDIM), 0.02),
        "fox_k_norm_g": 1.0 + nrm((N_EVEN, FOX_HDIM), 0.02),
        "ab_w_out": nrm((N_EVEN, MIX_WIDTH, D), MIX_WIDTH ** -0.5),
        "rwkv_mu": unif((N_ODD, 6, D), 0.0, 1.0),
        "rwkv_w_rkv": nrm((N_ODD, 3, D, D), D ** -0.5),
        "rwkv_w0": nrm((N_ODD, D), 0.5),
        "rwkv_w1": nrm((N_ODD, D, DECAY_LORA), D ** -0.5),
        "rwkv_w2": nrm((N_ODD, DECAY_LORA, D), 0.1 * DECAY_LORA ** -0.5),
        "rwkv_a0": nrm((N_ODD, D), 0.1),
        "rwkv_a1": nrm((N_ODD, D, AAA_LORA), D ** -0.5),
        "rwkv_a2": nrm((N_ODD, AAA_LORA, D), 0.1 * AAA_LORA ** -0.5),
        "rwkv_g1": nrm((N_ODD, D, GATE_LORA), D ** -0.5),
        "rwkv_g2": nrm((N_ODD, GATE_LORA, D), GATE_LORA ** -0.5),
        "rwkv_k_k": 0.85 + nrm((N_ODD, D), 0.02),
        "rwkv_k_a": 1.0 + nrm((N_ODD, D), 0.02),
        "rwkv_r_k": nrm((N_ODD, RWKV_HEADS, RWKV_HDIM), 0.1),
        "rwkv_lnx_g": 1.0 + nrm((N_ODD, D), 0.02),
        "rwkv_lnx_b": nrm((N_ODD, D), 0.02),
        "rwkv_w_o": nrm((N_ODD, D, D), D ** -0.5),
        "mlp_w_up": nrm((DEPTH, D, D_FF), D ** -0.5),
        "mlp_w_down": nrm((DEPTH, D_FF, D), D_FF ** -0.5),
    }


def reference(x, norm_mix_g, norm_ffn_g, ab_w_in, hgrn_lower_bounds, hgrn_norm_g,
              fox_forget_bias, fox_q_norm_g, fox_k_norm_g, ab_w_out, rwkv_mu, rwkv_w_rkv,
              rwkv_w0, rwkv_w1, rwkv_w2, rwkv_a0, rwkv_a1, rwkv_a2, rwkv_g1, rwkv_g2,
              rwkv_k_k, rwkv_k_a, rwkv_r_k, rwkv_lnx_g, rwkv_lnx_b, rwkv_w_o,
              mlp_w_up, mlp_w_down):
    lb_all = jnp.cumsum(jax.nn.softmax(hgrn_lower_bounds.astype(jnp.float32), axis=0), axis=0)
    h = x
    for layer in range(DEPTH):
        j = layer // 2
        hn = rmsnorm(h, norm_mix_g[layer])
        if layer % 2 == 0:
            mix = hgrn_fox_mixer(hn, ab_w_in[j], lb_all[layer], hgrn_norm_g[j],
                                 fox_forget_bias[j], fox_q_norm_g[j], fox_k_norm_g[j],
                                 ab_w_out[j])
        else:
            mix = rwkv7_mixer(hn, rwkv_mu[j], rwkv_w_rkv[j], rwkv_w0[j], rwkv_w1[j],
                              rwkv_w2[j], rwkv_a0[j], rwkv_a1[j], rwkv_a2[j], rwkv_g1[j],
                              rwkv_g2[j], rwkv_k_k[j], rwkv_k_a[j], rwkv_r_k[j],
                              rwkv_lnx_g[j], rwkv_lnx_b[j], rwkv_w_o[j])
        h = h + mix
        h = h + sqrelu_mlp(rmsnorm(h, norm_ffn_g[layer]), mlp_w_up[layer], mlp_w_down[layer])
    return h
```

```cpp
#include <hip/hip_runtime.h>
#include <hip/hip_cooperative_groups.h>
#include <hip/hip_bf16.h>
#include <cstdio>
#include <cstdint>
#include <cmath>
namespace cg = cooperative_groups;

namespace pg8 {
#define PG8_LAS __attribute__((address_space(3)))
typedef unsigned short bf16_t;
typedef short bf16x8 __attribute__((ext_vector_type(8)));
typedef float f32x4 __attribute__((ext_vector_type(4)));
typedef unsigned u32x4 __attribute__((ext_vector_type(4)));
constexpr int BM = 256, BK = 64, HALF = 128, HTB = HALF * BK * 2  , STAGE_BYTES = 8 * HTB, NXCD = 8, WGM = 8;

__host__ __device__ __forceinline__ int lds_byte(int r, int c) { const int st = (r >> 4) * 2 + (c >> 5), rr = r & 15, cc = c & 31, ob = rr * 64 + cc * 2; return st * 1024 + (ob ^ (((ob >> 9) & 1) << 5)); }
__host__ __device__ __forceinline__ void stage_rc(int b, int& R, int& C) { const int st = b / 1024, sb = b % 1024, swz = sb ^ (((sb >> 9) & 1) << 5); R = (st >> 1) * 16 + swz / 64; C = (st & 1) * 32 + (swz % 64) / 2; }
__host__ __device__ __forceinline__ int perm32(int rho) { const int n = rho >> 4, i = rho & 15; return 8 * (i >> 2) + 4 * n + (i & 3); }

struct Unit { int pm, pn; };
struct Gemm { const bf16_t* A; const bf16_t* Bt; int M, N, K, lda, amode; };
__device__ __forceinline__ const char* a_base(const Gemm& g, const Unit& u) {
    if (g.amode == 1) return (const char*)g.A + (size_t)((u.pm >> 4) * 4097 + 1 + (u.pm & 15) * 256) * g.lda * 2;
    if (g.amode == 3) return (const char*)g.A + (size_t)(u.pn >> 2) * ((size_t)65536 * 1024 * 2) + (size_t)u.pm * 256 * g.lda * 2;
    if (g.amode == 2) return (const char*)g.A + (size_t)u.pm * 256 * g.lda * 2 + (size_t)(u.pn >> 2) * 128;
    return (const char*)g.A + (size_t)u.pm * 256 * g.lda * 2;
}
struct StaticOrder {
    int nM, nN, nwg, G, c, rev = 0;
    __host__ __device__ void init(int M, int N, int G_, int c_) { nM = M / BM; nN = N / BM; nwg = nM * nN; G = G_; c = c_; }
    __host__ __device__ bool next(int i, Unit& u) const {
        const long L = (long)i * G + c; if (L >= nwg) return false;
        int wgid = (int)L; { const int q = nwg / NXCD, r = nwg % NXCD, xcd = wgid % NXCD, off = wgid / NXCD; wgid = (xcd < r ? xcd * (q + 1) : r * (q + 1) + (xcd - r) * q) + off; }
        const int nig = WGM * nN, gid = wgid / nig, fm = gid * WGM, gsz = (nM - fm) < WGM ? (nM - fm) : WGM;
        u.pm = fm + ((wgid % nig) % gsz); u.pn = (wgid % nig) / gsz; if (rev) u.pm = nM - 1 - u.pm; return true;
    }
    __device__ __forceinline__ void a_ready(const Unit&) const {}
    __device__ __forceinline__ void done(const Unit&) const {}
};
template <class Epi, class Sched, bool ALIGN_EPI = false, bool SP2 = false>
__device__ __forceinline__ void gemm_phase(PG8_LAS unsigned char* lds, const Gemm g, const Sched& S, const Epi& E) {
    int tid = threadIdx.x; asm volatile("" : "+v"(tid) :: "memory"); const int wid = __builtin_amdgcn_readfirstlane(tid >> 6), lane = tid & 63, wr = wid >> 2, wc = wid & 3, fr = lane & 15, fq = lane >> 4;
    const int K = g.K, nt = K / BK;
    unsigned voffA[2], voffB[2];
#pragma unroll
    for (int i = 0; i < 2; ++i) { int R, C; stage_rc(tid * 16 + i * 8192, R, C); const int Rb = Epi::PERM ? ((R & ~31) + perm32(R & 31)) : R;
        voffA[i] = (unsigned)(R * g.lda + C) * 2u; voffB[i] = (unsigned)(Rb * K + C) * 2u; }
    const size_t kstep = (size_t)(BK * 2);
    const size_t hstepB = (size_t)HALF * K * 2, hstepA = (size_t)HALF * g.lda * 2;
    const size_t tstepB = 2 * hstepB; const int shT = (g.amode == 1) ? 16 : (1 << 30); const size_t shB = (size_t)(g.lda + 1024) * 2;
    const unsigned ldsw = (unsigned)wid * 1024u;
    const int aoff = lds_byte(wr * 64 + fr, fq * 8), boff = lds_byte(wc * 32 + fr, fq * 8);
#define PG8_SA(b, h) (((b) * 2 + (h)) * HTB)
#define PG8_SB(b, h) ((4 + (b) * 2 + (h)) * HTB)
#define PG8_STAGE(bufoff, gbase, voff) do { _Pragma("unroll") for (int _i = 0; _i < 2; ++_i) \
        __builtin_amdgcn_global_load_lds((const unsigned*)((const char*)(gbase) + (voff)[_i]), (PG8_LAS unsigned*)(lds + (bufoff) + ldsw + _i * 8192), 16, 0, 0); } while (0)
#define PG8_LDA(dst, b, h) do { _Pragma("unroll") for (int m = 0; m < 4; ++m) _Pragma("unroll") for (int k = 0; k < 2; ++k) dst[m][k] = *(const PG8_LAS bf16x8*)(lds + PG8_SA(b, h) + aoff + m * 2048 + k * 1024); } while (0)
#define PG8_LDB(dst, b, h) do { _Pragma("unroll") for (int n = 0; n < 2; ++n) _Pragma("unroll") for (int k = 0; k < 2; ++k) dst[n][k] = *(const PG8_LAS bf16x8*)(lds + PG8_SB(b, h) + boff + n * 2048 + k * 1024); } while (0)
#define PG8_MMA(ai, bj, At, Bt) do { __builtin_amdgcn_s_setprio(1); _Pragma("unroll") for (int m = 0; m < 4; ++m) _Pragma("unroll") for (int n = 0; n < 2; ++n) _Pragma("unroll") for (int k = 0; k < 2; ++k) \
        acc[ai][bj][m][n] = __builtin_amdgcn_mfma_f32_16x16x32_bf16(Bt[n][k], At[m][k], acc[ai][bj][m][n], 0, 0, 0); __builtin_amdgcn_s_setprio(0); } while (0)
#define PG8_WAIT_V(n) asm volatile("s_waitcnt vmcnt(" #n ")" ::: "memory")
#define PG8_WAIT_L(n) asm volatile("s_waitcnt lgkmcnt(" #n ")" ::: "memory")
#define PG8_BAR __builtin_amdgcn_s_barrier()
#define PG8_SCHED __builtin_amdgcn_sched_barrier(0)
    Unit cur, nxt; int ui = 0;
    if (!S.next(0, cur)) return;
    f32x4 acc[2][2][4][2];
#pragma unroll
    for (int a = 0; a < 2; ++a)
#pragma unroll
        for (int b = 0; b < 2; ++b)
#pragma unroll
            for (int m = 0; m < 4; ++m)
#pragma unroll
                for (int n = 0; n < 2; ++n) acc[a][b][m][n] = (f32x4){0.f, 0.f, 0.f, 0.f};
    bf16x8 At[4][2], B0[2][2], B1[2][2];
    const char* cA = a_base(g, cur); const char* cB = (const char*)g.Bt + (size_t)cur.pn * tstepB;
    S.a_ready(cur);
    if constexpr (SP2) {
        PG8_STAGE(PG8_SB(0, 0), cB, voffB); PG8_STAGE(PG8_SB(0, 1), cB + hstepB, voffB); PG8_STAGE(PG8_SA(0, 0), cA, voffA); PG8_STAGE(PG8_SA(0, 1), cA + hstepA, voffA);
        if (wr == 1) PG8_BAR;
        PG8_WAIT_V(2); PG8_BAR;
        PG8_STAGE(PG8_SB(1, 0), cB + kstep, voffB); PG8_STAGE(PG8_SA(1, 0), cA + kstep, voffA); PG8_STAGE(PG8_SB(1, 1), cB + hstepB + kstep, voffB);
        PG8_WAIT_V(6); PG8_BAR;
    } else {
        PG8_STAGE(PG8_SB(0, 0), cB, voffB); PG8_STAGE(PG8_SA(0, 0), cA, voffA); PG8_STAGE(PG8_SB(0, 1), cB + hstepB, voffB); PG8_STAGE(PG8_SA(0, 1), cA + hstepA, voffA);
        if (wr == 1) PG8_BAR;
        PG8_WAIT_V(4); PG8_BAR;
        PG8_STAGE(PG8_SB(1, 0), cB + kstep, voffB); PG8_STAGE(PG8_SA(1, 0), cA + kstep, voffA); PG8_STAGE(PG8_SB(1, 1), cB + hstepB + kstep, voffB);
        PG8_WAIT_V(6); PG8_BAR;
    }
    for (;;) {
        const bool has_next = S.next(ui + 1, nxt);
        const char* nA = has_next ? a_base(g, nxt) : cA; const char* nB = has_next ? (const char*)g.Bt + (size_t)nxt.pn * tstepB : cB;
        for (int t = 0; t < nt; t += 2) {
            const bool last = (t == nt - 2);
            const char* a1 = cA + (size_t)(t + 1) * kstep - ((t + 1) >= shT ? shB : 0);
            const char* a2 = last ? nA : cA + (size_t)(t + 2) * kstep - ((t + 2) >= shT ? shB : 0); const char* b2 = last ? nB : cB + (size_t)(t + 2) * kstep;
            const char* a3 = last ? nA + kstep : cA + (size_t)(t + 3) * kstep - ((t + 3) >= shT ? shB : 0); const char* b3 = b2 + kstep;
            if (last && has_next) S.a_ready(nxt);
            if constexpr (SP2) {
            PG8_LDB(B0, 0, 0); PG8_LDB(B1, 0, 1); PG8_SCHED; PG8_LDA(At, 0, 0); PG8_STAGE(PG8_SA(1, 1), a1 + hstepA, voffA);
            PG8_WAIT_V(8); PG8_WAIT_L(0); PG8_BAR; PG8_MMA(0, 0, At, B0); PG8_MMA(0, 1, At, B1); PG8_BAR; PG8_SCHED;
            PG8_LDA(At, 0, 1); PG8_STAGE(PG8_SB(0, 0), b2, voffB); PG8_STAGE(PG8_SB(0, 1), b2 + hstepB, voffB); PG8_STAGE(PG8_SA(0, 0), a2, voffA);
            PG8_WAIT_V(8); PG8_WAIT_L(0); PG8_BAR; PG8_MMA(1, 0, At, B0); PG8_MMA(1, 1, At, B1); PG8_BAR; PG8_SCHED;
            PG8_LDB(B0, 1, 0); PG8_LDB(B1, 1, 1); PG8_SCHED; PG8_LDA(At, 1, 0); PG8_STAGE(PG8_SA(0, 1), a2 + hstepA, voffA);
            PG8_WAIT_V(8); PG8_WAIT_L(0); PG8_BAR; PG8_MMA(0, 0, At, B0); PG8_MMA(0, 1, At, B1); PG8_BAR; PG8_SCHED;
            PG8_LDA(At, 1, 1); PG8_STAGE(PG8_SB(1, 0), b3, voffB); PG8_STAGE(PG8_SB(1, 1), b3 + hstepB, voffB); PG8_STAGE(PG8_SA(1, 0), a3, voffA);
            PG8_WAIT_V(8); PG8_WAIT_L(0); PG8_BAR; PG8_MMA(1, 0, At, B0); PG8_MMA(1, 1, At, B1); PG8_BAR; PG8_SCHED;
            } else {
            PG8_LDB(B0, 0, 0); PG8_SCHED; PG8_LDA(At, 0, 0); PG8_STAGE(PG8_SA(1, 1), a1 + hstepA, voffA);
            PG8_WAIT_L(8); PG8_BAR; PG8_WAIT_L(0); PG8_MMA(0, 0, At, B0); PG8_BAR; PG8_SCHED;
            PG8_LDB(B1, 0, 1); PG8_STAGE(PG8_SB(0, 0), b2, voffB);
            PG8_BAR; PG8_WAIT_L(0); PG8_MMA(0, 1, At, B1); PG8_BAR;
            PG8_LDA(At, 0, 1); PG8_STAGE(PG8_SA(0, 0), a2, voffA);
            PG8_BAR; PG8_WAIT_L(0); PG8_MMA(1, 0, At, B0); PG8_BAR; PG8_SCHED;
            PG8_STAGE(PG8_SB(0, 1), b2 + hstepB, voffB);
            PG8_WAIT_V(6); PG8_BAR; PG8_MMA(1, 1, At, B1); PG8_BAR;
            PG8_LDB(B0, 1, 0); PG8_SCHED; PG8_LDA(At, 1, 0); PG8_STAGE(PG8_SA(0, 1), a2 + hstepA, voffA);
            PG8_WAIT_L(8); PG8_BAR; PG8_WAIT_L(0); PG8_MMA(0, 0, At, B0); PG8_BAR; PG8_SCHED;
            PG8_LDB(B1, 1, 1); PG8_STAGE(PG8_SB(1, 0), b3, voffB);
            PG8_BAR; PG8_WAIT_L(0); PG8_MMA(0, 1, At, B1); PG8_BAR;
            PG8_LDA(At, 1, 1); PG8_STAGE(PG8_SA(1, 0), a3, voffA);
            PG8_BAR; PG8_WAIT_L(0); PG8_MMA(1, 0, At, B0); PG8_BAR; PG8_SCHED;
            PG8_STAGE(PG8_SB(1, 1), b3 + hstepB, voffB);
            PG8_WAIT_V(6); PG8_BAR; PG8_MMA(1, 1, At, B1); PG8_BAR;
            }
        }
        if constexpr (ALIGN_EPI) { if (wr == 0) PG8_BAR; }
        if constexpr (!Epi::AFTER_DRAIN) { E(acc, cur, wr, wc, fr, fq); S.done(cur); }
        if (!has_next) break;
#pragma unroll
        for (int a = 0; a < 2; ++a)
#pragma unroll
            for (int b = 0; b < 2; ++b)
#pragma unroll
                for (int m = 0; m < 4; ++m)
#pragma unroll
                    for (int n = 0; n < 2; ++n) acc[a][b][m][n] = (f32x4){0.f, 0.f, 0.f, 0.f};
        cur = nxt; cA = nA; cB = nB; ++ui;
        if constexpr (ALIGN_EPI) { if (wr == 1) PG8_BAR; }
    }
    PG8_WAIT_V(0);
    if constexpr (!ALIGN_EPI) { if (wr == 0) PG8_BAR; }
    PG8_BAR;
    if constexpr (Epi::AFTER_DRAIN) { E.fused(acc, cur, wr, wc, fr, fq, lds, wid, lane); S.done(cur); }
#undef PG8_SA
#undef PG8_SB
#undef PG8_STAGE
#undef PG8_LDA
#undef PG8_LDB
#undef PG8_MMA
#undef PG8_WAIT_V
#undef PG8_WAIT_L
#undef PG8_BAR
#undef PG8_SCHED
}
}
#include <hip/hip_bf16.h>
#include <cmath>
namespace attn_body {
using bf16=__hip_bfloat16;
using bf16x8=__attribute__((ext_vector_type(8)))short;
using s16x4=__attribute__((ext_vector_type(4)))short;
using f32x16=__attribute__((ext_vector_type(16)))float;
using u32x4=__attribute__((ext_vector_type(4)))unsigned;
constexpr int BATCH=16,NHEAD=8,SEQ=4096,D=64,DM=512,OPITCH=1024;
constexpr int NW=8,QBLK=32,QB=QBLK*NW,KVBLK=64,NQB=SEQ/QB;
constexpr int ATTN_PITCH=DM, ATTN_UNIT_ROWS=QB;
__device__ __forceinline__ int crow(int r,int hi){return (r&3)+8*(r>>2)+4*hi;}
#define SBAR() __builtin_amdgcn_sched_barrier(0)
__device__ __forceinline__ void cmask(f32x16&p0,f32x16&p1,int jb,int qrel,int hi){
  const float NEG=-INFINITY; int kb=64*jb+4*hi;
  #pragma unroll
  for(int r=0;r<16;++r){int kv=kb+(r&3)+8*(r>>2); if(kv>qrel)p0[r]=NEG; if(kv+32>qrel)p1[r]=NEG;}
}

constexpr int NSLOT=3, SLOTB=8192;
constexpr int LDS_K=0, LDS_V=NSLOT*SLOTB, LDS_WS=2*NSLOT*SLOTB, LDS_OST=LDS_WS+NW*64*4, LDS_CB=LDS_OST+NW*4096, LDS_BYTES=LDS_CB+SEQ*4;
constexpr float C2=0.125f*1.4426950408889634f;
__device__ __forceinline__ void glds16(const void*gsrc,unsigned lds_dst){unsigned keep;
  asm volatile("s_mov_b32 %0, m0\n\ts_mov_b32 m0, %2\n\ts_nop 0\n\tglobal_load_lds_dwordx4 %1, off\n\ts_mov_b32 m0, %0":"=&s"(keep):"v"(gsrc),"s"(lds_dst):"memory");}
__device__ __forceinline__ float max3f(float a,float b,float c){float r;asm("v_max3_f32 %0, %1, %2, %3":"=v"(r):"v"(a),"v"(b),"v"(c));return r;}
__device__ __forceinline__ float max2f(float a,float b){float r;asm("v_max_f32_e32 %0, %1, %2":"=v"(r):"v"(a),"v"(b));return r;}
__device__ __forceinline__ float fadd_s(float a,float b){float r;asm("v_add_f32_e32 %0, %1, %2":"=v"(r):"v"(a),"v"(b));return r;}
__device__ __forceinline__ float fsub_s(float a,float b){float r;asm("v_sub_f32_e32 %0, %1, %2":"=v"(r):"v"(a),"v"(b));return r;}
typedef float f32x2_t __attribute__((ext_vector_type(2))); typedef __bf16 bf16x2_t __attribute__((ext_vector_type(2)));
__device__ __forceinline__ unsigned cvtpk_s(float lo,float hi){f32x2_t v={lo,hi};bf16x2_t b=__builtin_convertvector(v,bf16x2_t);return __builtin_bit_cast(unsigned,b);}
#define WAIT_BAR(N) asm volatile("s_waitcnt vmcnt(" #N ") lgkmcnt(0)\n\ts_barrier":::"memory")

__device__ __forceinline__ void qkt(f32x16&p0,f32x16&p1,const char*Kslot,const bf16x8*qr,const f32x16&negm,int r32,int hi){
  const char*kb=Kslot+hi*1024+r32*16;
  #pragma unroll
  for(int d0=0;d0<4;++d0){
    const bf16x8 b0=*reinterpret_cast<const bf16x8*>(kb+d0*2048);
    const bf16x8 b1=*reinterpret_cast<const bf16x8*>(kb+d0*2048+512);
    p0=__builtin_amdgcn_mfma_f32_32x32x16_bf16(b0,qr[d0],p0,0,0,0);p1=__builtin_amdgcn_mfma_f32_32x32x16_bf16(b1,qr[d0],p1,0,0,0);}
}
typedef __attribute__((address_space(3))) const char* lds_cptr;
typedef short v4i16_t __attribute__((ext_vector_type(4)));
__device__ __forceinline__ void kload8(bf16x8*kf,lds_cptr kp){
  kf[0]=*(const __attribute__((address_space(3))) bf16x8*)(kp);      kf[1]=*(const __attribute__((address_space(3))) bf16x8*)(kp+512);
  kf[2]=*(const __attribute__((address_space(3))) bf16x8*)(kp+2048); kf[3]=*(const __attribute__((address_space(3))) bf16x8*)(kp+2560);
  kf[4]=*(const __attribute__((address_space(3))) bf16x8*)(kp+4096); kf[5]=*(const __attribute__((address_space(3))) bf16x8*)(kp+4608);
  kf[6]=*(const __attribute__((address_space(3))) bf16x8*)(kp+6144); kf[7]=*(const __attribute__((address_space(3))) bf16x8*)(kp+6656);
}
__device__ __forceinline__ void kload2(bf16x8*kf,lds_cptr kp,int j){ kf[2*j]=*(const __attribute__((address_space(3))) bf16x8*)(kp+j*2048); kf[2*j+1]=*(const __attribute__((address_space(3))) bf16x8*)(kp+j*2048+512); }
__device__ __forceinline__ s16x4 vtr(lds_cptr p){ return __builtin_bit_cast(s16x4,__builtin_amdgcn_ds_read_tr16_b64_v4i16((__attribute__((address_space(3))) v4i16_t*)p)); }
__device__ __forceinline__ float rowmax(const f32x16&p0,const f32x16&p1){
  float a=max3f(p0[0],p0[1],p1[0]),b=max3f(p0[2],p0[3],p1[1]);a=max3f(a,p1[2],p1[3]);
  #pragma unroll
  for(int r=4;r<16;r+=4){a=max3f(a,p0[r],p0[r+1]);b=max3f(b,p0[r+2],p0[r+3]);a=max3f(a,p1[r],p1[r+1]);b=max3f(b,p1[r+2],p1[r+3]);}
  const float m=max2f(a,b);
  auto rr=__builtin_amdgcn_permlane32_swap(__float_as_uint(m),__float_as_uint(m),false,false);
  return max2f(__uint_as_float(rr[0]),__uint_as_float(rr[1]));
}
__device__ __forceinline__ void pv(f32x16*o,int vb,bf16x8 pa0,bf16x8 pa1,bf16x8 pa2,bf16x8 pa3){
  #pragma unroll
  for(int d0=0;d0<2;++d0){s16x4 lo[4],hi[4];
    #pragma unroll
    for(int ks=0;ks<4;++ks){
      asm volatile("ds_read_b64_tr_b16 %0,%1 offset:%c2":"=&v"(lo[ks]):"v"(vb),"i"(d0*4096+ks*1024):"memory");
      asm volatile("ds_read_b64_tr_b16 %0,%1 offset:%c2":"=&v"(hi[ks]):"v"(vb),"i"(d0*4096+ks*1024+512):"memory");}
    asm volatile("s_waitcnt lgkmcnt(0)":::"memory");SBAR();
    #define PK(k) (bf16x8){lo[k][0],lo[k][1],lo[k][2],lo[k][3],hi[k][0],hi[k][1],hi[k][2],hi[k][3]}
    o[d0]=__builtin_amdgcn_mfma_f32_32x32x16_bf16(pa0,PK(0),o[d0],0,0,0);
    o[d0]=__builtin_amdgcn_mfma_f32_32x32x16_bf16(pa1,PK(1),o[d0],0,0,0);
    o[d0]=__builtin_amdgcn_mfma_f32_32x32x16_bf16(pa2,PK(2),o[d0],0,0,0);
    o[d0]=__builtin_amdgcn_mfma_f32_32x32x16_bf16(pa3,PK(3),o[d0],0,0,0);
    #undef PK
  }
}


typedef __attribute__((address_space(3))) const float* lds_fptr;
typedef float f32x4a __attribute__((ext_vector_type(4)));
__device__ __forceinline__ void bias_scale(f32x16&p0,f32x16&p1,lds_fptr rk,lds_fptr cb,float mhat,int hi){
  #pragma unroll
  for(int j=0;j<4;++j){
    const f32x4a r0=*(const __attribute__((address_space(3))) f32x4a*)(rk+8*j+4*hi), c0=*(const __attribute__((address_space(3))) f32x4a*)(cb+8*j+4*hi);
    const f32x4a r1=*(const __attribute__((address_space(3))) f32x4a*)(rk+32+8*j+4*hi), c1=*(const __attribute__((address_space(3))) f32x4a*)(cb+32+8*j+4*hi);
    #pragma unroll
    for(int i=0;i<4;++i){ p0[4*j+i]=__builtin_fmaf(p0[4*j+i],r0[i],c0[i])-mhat; p1[4*j+i]=__builtin_fmaf(p1[4*j+i],r1[i],c1[i])-mhat; }
    SBAR();
  }
}
#ifndef ATTN_STORE16
#define ATTN_STORE16(p,v) (*(u32x4*)(p)=(v))
#endif
template<int THRL> __device__ __forceinline__ void attn_unit(int b,int h,int qb,const bf16*Q,const bf16*__restrict__ K,const bf16*__restrict__ V,bf16*O,const float*__restrict__ SSK,const float*__restrict__ CBG,const float*__restrict__ GQ,const float*__restrict__ GK,const _Float16*__restrict__ BG,char*shm){
  int tid=threadIdx.x; asm volatile("":"+v"(tid)::"memory"); const int lane=tid&63,r32=lane&31,hi=lane>>5; const int wid=__builtin_amdgcn_readfirstlane(tid>>6);
  const long rowbase=(long)b*SEQ; const int q0=qb*QB;
  const bf16*Qw=Q+(rowbase+q0+wid*QBLK)*DM+h*D;
  int ts=0;
  { const float*cbg=CBG+(size_t)(b*NHEAD+h)*SEQ; float gqm=fabsf(GQ[lane]),gkm=fabsf(GK[lane]);
    #pragma unroll
    for(int o_=1;o_<64;o_<<=1){ gqm=fmaxf(gqm,__shfl_xor(gqm,o_)); gkm=fmaxf(gkm,__shfl_xor(gkm,o_)); }
    const float B2=64.0f*C2*gqm*gkm*1.1f+1.0f, thr=cbg[q0]-2.0f*B2-46.0f; const int npre=q0/KVBLK;
    const float ve=(lane<npre)?cbg[64*lane+63]:3.0e38f;
    ts=__builtin_popcountll(__ballot(ve<thr))&~1; ts=__builtin_amdgcn_readfirstlane(ts); }
  const bf16*Kh=K+(rowbase+(long)ts*KVBLK)*DM+h*D,*Vh=V+(rowbase+(long)ts*KVBLK)*DM+h*D;
  const lds_cptr shm3=(lds_cptr)shm;
  const unsigned lds0=(unsigned)(uintptr_t)shm;
  float*wsf=(float*)(shm+LDS_WS)+wid*64;
  const bf16*ksrc=Kh+(long)lane*DM+wid*8;
  const bf16*vsrc=Vh+(long)(16*(wid&3)+(lane>>2))*DM+(wid>>2)*32+(lane&3)*8;
  const unsigned kdst=lds0+LDS_K+wid*1024, vdst=lds0+LDS_V+wid*1024;
  #define DMA_K(t,slot) glds16(ksrc+(long)(t)*KVBLK*DM,(unsigned)__builtin_amdgcn_readfirstlane(kdst+(slot)))
  #define DMA_V(t,slot) glds16(vsrc+(long)(t)*KVBLK*DM,(unsigned)__builtin_amdgcn_readfirstlane(vdst+(slot)))
  const int vb0=(int)(lds0+LDS_V)+((lane>>4)&1)*32+(lane&3)*8+(4*hi+((lane&15)>>2))*64;
  const char*Kbase=shm+LDS_K; bf16x8 kf[8];
  const lds_cptr kp0=shm3+LDS_K+hi*1024+r32*16; const lds_cptr vp0=shm3+LDS_V+((lane>>4)&1)*32+(lane&3)*8+(4*hi+((lane&15)>>2))*64;
  const int NT=(q0+QB)/KVBLK-ts;
  { float*cbl=(float*)(shm+LDS_CB); const int nk=q0+QB;
    for(int s=ts*KVBLK+tid;s<nk;s+=NW*64){ cbl[s-ts*KVBLK]=CBG[(size_t)(b*NHEAD+h)*SEQ+s]; } }
  const lds_fptr cb3=(lds_fptr)(shm3+LDS_CB);
  DMA_K(0,0);DMA_V(0,0);DMA_K(1,SLOTB);
  bf16x8 qr[4];
  #pragma unroll
  for(int d0=0;d0<4;++d0)qr[d0]=*reinterpret_cast<const bf16x8*>(&Qw[(long)r32*DM+d0*16+hi*8]);
  { float qss=0.f;
    #pragma unroll
    for(int d0=0;d0<4;++d0)
      #pragma unroll
      for(int j=0;j<8;++j){ const float qv=__uint_as_float(((unsigned)(unsigned short)qr[d0][j])<<16); qss+=qv*qv; }
    qss+=__shfl_xor(qss,32);
    const float qrs=rsqrtf(qss*(1.0f/64.0f)+1e-6f)*C2;
    #pragma unroll
    for(int d0=0;d0<4;++d0){ unsigned w_[4];
      #pragma unroll
      for(int j=0;j<8;j+=2){ const int dd=d0*16+hi*8+j;
        const float v0=__uint_as_float(((unsigned)(unsigned short)qr[d0][j])<<16)*qrs*GQ[dd];
        const float v1=__uint_as_float(((unsigned)(unsigned short)qr[d0][j+1])<<16)*qrs*GQ[dd+1];
        w_[j>>1]=cvtpk_s(v0,v1); }
      qr[d0]=__builtin_bit_cast(bf16x8,(u32x4){w_[0],w_[1],w_[2],w_[3]}); } }
  float mhat=0.f,l_reg=0.f;f32x16 o[2];o[0]=f32x16{};o[1]=f32x16{};const f32x16 negm=f32x16{};
  #define CINIT1(C0_,off_,t_,mh_) do{ const lds_fptr cbp_=cb3+64*(t_)+4*hi+(off_); \
    _Pragma("unroll") for(int j_=0;j_<4;++j_){ const f32x4a c0_=*(const __attribute__((address_space(3))) f32x4a*)(cbp_+8*j_); \
      _Pragma("unroll") for(int i_=0;i_<4;++i_){ C0_[4*j_+i_]=c0_[i_]-(mh_); } } }while(0)
  #define CINIT(C0_,C1_,t_,mh_) do{ CINIT1(C0_,0,t_,mh_); CINIT1(C1_,32,t_,mh_); }while(0)
  const int qrel=wid*QBLK+r32;
  #define CMASK(P0,P1,t) do{int jb_=(t)-(NT-4); if(jb_>=0)cmask(P0,P1,jb_,qrel,hi);}while(0)
  bool resc=false;
  #define START(P0,P1) do{ const float rm=rowmax(P0,P1); resc=false; \
    { const float dl=rm; mhat=fadd_s(mhat,dl); \
      _Pragma("unroll") for(int r=0;r<16;++r){P0[r]=fsub_s(P0[r],dl);P1[r]=fsub_s(P1[r],dl);} \
      } \
    _Pragma("unroll") for(int r=0;r<16;++r)P0[r]=__builtin_amdgcn_exp2f(P0[r]); }while(0)
  #define RESC() do{ if(resc){ asm volatile("s_waitcnt lgkmcnt(0)":::"memory"); \
      _Pragma("unroll") for(int d_=0;d_<2;++d_) _Pragma("unroll") for(int r=0;r<16;++r)o[d_][r]*=wsf[crow(r,hi)]; } }while(0)
  f32x16 pA0,pA1,pB0,pB1;
  int sl_prev=0,sl_cur=0,sl_next=SLOTB;
  #define ROT() do{sl_prev=sl_cur;sl_cur=sl_next;sl_next=(sl_next==(NSLOT-1)*SLOTB)?0:sl_next+SLOTB;}while(0)
  DMA_K(2,2*SLOTB);
  WAIT_BAR(3);
  CINIT(pA0,pA1,0,0.f);qkt(pA0,pA1,Kbase,qr,negm,r32,hi);asm volatile("s_nop 15\n\ts_nop 7":"+v"(pA0),"+v"(pA1));CMASK(pA0,pA1,0);
  START(pA0,pA1);
  _Pragma("unroll") for(int r=0;r<16;++r)pA1[r]=__builtin_amdgcn_exp2f(pA1[r]);
  WAIT_BAR(0);
  DMA_K(3,0);DMA_V(1,SLOTB);
  ROT();
  kload8(kf,kp0+sl_cur);
  WAIT_BAR(2);
  s16x4 vlo[8],vhi[8]; u32x4 pw0,pw1,pw2,pw3;
  #define PKW(P,B) cvtpk_s(P[B],P[B+1])
  #define PAF(k) __builtin_bit_cast(bf16x8,pw##k)
  #define VFR(i) (bf16x8){vlo[i][0],vlo[i][1],vlo[i][2],vlo[i][3],vhi[i][0],vhi[i][1],vhi[i][2],vhi[i][3]}
  #define PIN(x) asm volatile("":"+v"(x))
  #define MX3(a,b,c) __builtin_fmaxf(__builtin_fmaxf((a),(b)),(c))
  #define GAPA(MF,A0,A1,A2,A3,W0,W1,PW) do{ MF; sacc+=A0; sacc+=A1; sacc+=A2; sacc+=A3; PIN(sacc); W0; W1; PIN(PW); SBAR(); }while(0)
  #define EX(v) __builtin_amdgcn_exp2f(v)
  #define GAPB(MF,X,B) do{ MF; X[B]=EX(X[B]); X[B+1]=EX(X[B+1]); X[B+2]=EX(X[B+2]); X[B+3]=EX(X[B+3]); PIN(X); SBAR(); }while(0)
  #define VRD(i) do{ vlo[i]=vtr(vp_+(((i)>>2)*4096+((i)&3)*1024)); vhi[i]=vtr(vp_+(((i)>>2)*4096+((i)&3)*1024+512)); }while(0)
  #define KRD(G,j) do{ if(G){ kload2(kf,kp0+sl_next,j); SBAR(); } }while(0)
  #define STEP(C0,C1,P0,P1,t,GK,GV,GL) do{ SBAR(); \
    const lds_cptr vp_=vp0+sl_prev; CINIT1(C0,0,t,mhat); SBAR(); \
    VRD(0); SBAR(); float sacc=(P0[0]+P0[1]); \
    GAPA(C0=__builtin_amdgcn_mfma_f32_32x32x16_bf16(kf[0],qr[0],C0,0,0,0), P0[2],P0[3],P0[4],P0[5],     pw0[0]=PKW(P0,0), pw0[1]=PKW(P0,2), pw0); \
    CINIT1(C1,32,t,mhat); SBAR(); VRD(4); SBAR(); GAPA(C1=__builtin_amdgcn_mfma_f32_32x32x16_bf16(kf[1],qr[0],C1,0,0,0), P0[6],P0[7],P0[8],P0[9],     pw0[2]=PKW(P0,4), pw0[3]=PKW(P0,6), pw0); \
    VRD(1); SBAR(); GAPA(C0=__builtin_amdgcn_mfma_f32_32x32x16_bf16(kf[2],qr[1],C0,0,0,0),   P0[10],P0[11],P0[12],P0[13], pw1[0]=PKW(P0,8), pw1[1]=PKW(P0,10), pw1); \
    VRD(5); SBAR(); GAPA(C1=__builtin_amdgcn_mfma_f32_32x32x16_bf16(kf[3],qr[1],C1,0,0,0),   P0[14],P0[15],P1[0],P1[1],   pw1[2]=PKW(P0,12),pw1[3]=PKW(P0,14), pw1); \
    VRD(2); SBAR(); GAPA(C0=__builtin_amdgcn_mfma_f32_32x32x16_bf16(kf[4],qr[2],C0,0,0,0),   P1[2],P1[3],P1[4],P1[5],     pw2[0]=PKW(P1,0), pw2[1]=PKW(P1,2), pw2); \
    VRD(6); SBAR(); GAPA(C1=__builtin_amdgcn_mfma_f32_32x32x16_bf16(kf[5],qr[2],C1,0,0,0),   P1[6],P1[7],P1[8],P1[9],     pw2[2]=PKW(P1,4), pw2[3]=PKW(P1,6), pw2); \
    VRD(3); SBAR(); GAPA(C0=__builtin_amdgcn_mfma_f32_32x32x16_bf16(kf[6],qr[3],C0,0,0,0),   P1[10],P1[11],P1[12],P1[13], pw3[0]=PKW(P1,8), pw3[1]=PKW(P1,10), pw3); \
    VRD(7); SBAR(); GAPA(C1=__builtin_amdgcn_mfma_f32_32x32x16_bf16(kf[7],qr[3],C1,0,0,0),   P1[14],P1[15],0.f,0.f,       pw3[2]=PKW(P1,12),pw3[3]=PKW(P1,14), pw3); \
    l_reg+=sacc; \
    if(GK){DMA_K((t)+3,sl_cur);} if(GV){DMA_V((t)+1,sl_next);} \
    CMASK(C0,C1,t); \
    { float a=MX3(C0[0],C0[1],C1[0]),b=MX3(C0[2],C0[3],C1[1]); a=MX3(a,C1[2],C1[3]); \
      _Pragma("unroll") for(int r=4;r<16;r+=4){a=MX3(a,C0[r],C0[r+1]);b=MX3(b,C0[r+2],C0[r+3]);a=MX3(a,C1[r],C1[r+1]);b=MX3(b,C1[r+2],C1[r+3]);} \
      float rm=__builtin_fmaxf(a,b); { auto rr=__builtin_amdgcn_permlane32_swap(__float_as_uint(rm),__float_as_uint(rm),false,false); rm=__builtin_fmaxf(__uint_as_float(rr[0]),__uint_as_float(rr[1])); } \
      resc=false; \
      if(__builtin_expect(__any(rm>(float)THRL),0)){ const float dl=__builtin_fmaxf(rm,0.f); mhat+=dl; \
        _Pragma("unroll") for(int r=0;r<16;++r){C0[r]-=dl;C1[r]-=dl;} \
        const float f=__builtin_amdgcn_exp2f(-dl); l_reg*=f; if(hi==0)wsf[r32]=f; resc=true; } } \
    SBAR(); \
    GAPB(o[0]=__builtin_amdgcn_mfma_f32_32x32x16_bf16(PAF(0),VFR(0),o[0],0,0,0), C0,0); \
    GAPB(o[1]=__builtin_amdgcn_mfma_f32_32x32x16_bf16(PAF(0),VFR(4),o[1],0,0,0), C0,4); \
    KRD(GL,0); GAPB(o[0]=__builtin_amdgcn_mfma_f32_32x32x16_bf16(PAF(1),VFR(1),o[0],0,0,0), C0,8); \
    KRD(GL,1); GAPB(o[1]=__builtin_amdgcn_mfma_f32_32x32x16_bf16(PAF(1),VFR(5),o[1],0,0,0), C0,12); \
    KRD(GL,2); GAPB(o[0]=__builtin_amdgcn_mfma_f32_32x32x16_bf16(PAF(2),VFR(2),o[0],0,0,0), C1,0); \
    KRD(GL,3); GAPB(o[1]=__builtin_amdgcn_mfma_f32_32x32x16_bf16(PAF(2),VFR(6),o[1],0,0,0), C1,4); \
    GAPB(o[0]=__builtin_amdgcn_mfma_f32_32x32x16_bf16(PAF(3),VFR(3),o[0],0,0,0), C1,8); \
    GAPB(o[1]=__builtin_amdgcn_mfma_f32_32x32x16_bf16(PAF(3),VFR(7),o[1],0,0,0), C1,12); \
    }while(0)
  int t=1;
  #undef CMASK
  #define CMASK(P0,P1,t) do{}while(0)
  for(;t+5<NT;t+=2){
    STEP(pB0,pB1,pA0,pA1,t,true,true,true);     WAIT_BAR(2); RESC(); ROT();
    STEP(pA0,pA1,pB0,pB1,t+1,true,true,true);   WAIT_BAR(2); RESC(); ROT();
  }
  #undef CMASK
  #define CMASK(P0,P1,t) do{int jb_=(t)-(NT-4); if(jb_>=0)cmask(P0,P1,jb_,qrel,hi);}while(0)
  #define ENDW(tt) do{ if((tt)+3<NT){WAIT_BAR(2);} else if((tt)+2<NT){WAIT_BAR(1);} else {WAIT_BAR(0);} }while(0)
  for(;t+1<NT;t+=2){
    STEP(pB0,pB1,pA0,pA1,t,(t+3<NT),(t+1<NT),(t+1<NT));       ENDW(t);   RESC(); ROT();
    STEP(pA0,pA1,pB0,pB1,t+1,(t+4<NT),(t+2<NT),(t+2<NT));     ENDW(t+1); RESC(); ROT();
  }
  STEP(pB0,pB1,pA0,pA1,NT-1,false,false,false); RESC();
  { float sacc=pB0[0]+pB0[1]; _Pragma("unroll") for(int r=2;r<16;++r)sacc+=pB0[r]; _Pragma("unroll") for(int r=0;r<16;++r)sacc+=pB1[r]; l_reg+=sacc;
    pw0=(u32x4){PKW(pB0,0),PKW(pB0,2),PKW(pB0,4),PKW(pB0,6)};pw1=(u32x4){PKW(pB0,8),PKW(pB0,10),PKW(pB0,12),PKW(pB0,14)};pw2=(u32x4){PKW(pB1,0),PKW(pB1,2),PKW(pB1,4),PKW(pB1,6)};pw3=(u32x4){PKW(pB1,8),PKW(pB1,10),PKW(pB1,12),PKW(pB1,14)};
    SBAR(); pv(o,vb0+sl_cur,PAF(0),PAF(1),PAF(2),PAF(3)); }
  #undef PKW
  #undef PAF
  #undef VFR
  #undef PIN
  #undef MX3
  #undef GAPA
  #undef GAPB
  #undef EX
  #undef VRD
  #undef KRD
  #undef STEP
  #undef ENDW
  {auto rr=__builtin_amdgcn_permlane32_swap(__float_as_uint(l_reg),__float_as_uint(l_reg),false,false);l_reg=__uint_as_float(rr[0])+__uint_as_float(rr[1]);}
  if(hi==0)wsf[32+r32]=l_reg;asm volatile("s_waitcnt lgkmcnt(0)":::"memory");
  float rli[16];
  #pragma unroll
  for(int r=0;r<16;++r)rli[r]=__builtin_amdgcn_rcpf(wsf[32+crow(r,hi)]);
  bf16*Ow=O+(rowbase+q0+wid*QBLK)*OPITCH+h*D; const _Float16*Gw=BG+(rowbase+q0+wid*QBLK)*DM+h*D;
  { bf16*stg=(bf16*)(shm+LDS_OST)+wid*2048;
    #pragma unroll
    for(int r=0;r<16;++r){const int orow=crow(r,hi);
      #pragma unroll
      for(int d0=0;d0<2;++d0)stg[orow*64+d0*32+r32]=__float2bfloat16(o[d0][r]*rli[r]);}
    asm volatile("s_waitcnt lgkmcnt(0)":::"memory");
    #pragma unroll
    for(int i=0;i<4;++i){const int row=i*8+(lane>>3),ch=lane&7; const u32x4 v=*(const u32x4*)(stg+row*64+ch*8);
      typedef _Float16 h8_t __attribute__((ext_vector_type(8))); const h8_t gg=*(const h8_t*)(Gw+(long)row*DM+ch*8); u32x4 w;
      #pragma unroll
      for(int j=0;j<4;++j){ const float lo=__uint_as_float(v[j]<<16)*(float)gg[2*j], hi_=__uint_as_float(v[j]&0xffff0000u)*(float)gg[2*j+1]; w[j]=cvtpk_s(lo,hi_); }
      ATTN_STORE16(Ow+(long)row*OPITCH+ch*8,w);} }
  asm volatile("s_waitcnt lgkmcnt(0)\n\ts_barrier":::"memory");
  #undef DMA_K
  #undef DMA_V
  #undef CINIT
  #undef CINIT1
  #undef CMASK
  #undef START
  #undef RESC
  #undef ROT
}
constexpr int ATTN_LDS_BYTES=LDS_BYTES;
struct AttnTensors { const bf16* Q; const bf16* K; const bf16* V; bf16* O; const float* SSK; const float* CBG; const float* GQ; const float* GK; const _Float16* BG; };
struct AttnUnit { int bh; int qb; };
struct StaticOrder {
  int vcu,nmine,base;
  __device__ __forceinline__ explicit StaticOrder(int grid,int block):vcu(block),nmine(block>=128?14:2),base(block>=128?0:1792){}
  __device__ __forceinline__ bool next(int i,AttnUnit&u)const{ if(i>=nmine)return false; const int L=base+i*128+(vcu&127); u.bh=L>>4; u.qb=L&15; return true; }
  __device__ __forceinline__ void a_ready(const AttnUnit&)const{}
  __device__ __forceinline__ void done(const AttnUnit&)const{}
};
template<class Sched,int THRL=8> __device__ __forceinline__ void attn_phase(char*lds,const AttnTensors&T,const Sched&S){
  AttnUnit u;
  for(int i=0;S.next(i,u);++i){ S.a_ready(u); attn_unit<THRL>(u.bh/NHEAD,u.bh%NHEAD,u.qb,T.Q,T.K,T.V,T.O,T.SSK,T.CBG,T.GQ,T.GK,T.BG,lds); S.done(u); }
}
#undef SBAR
#undef WAIT_BAR
}
#define DI __device__ __forceinline__
#define LAS __attribute__((address_space(3)))
typedef unsigned short u16;
typedef float f32x4 __attribute__((ext_vector_type(4)));
typedef unsigned u32x4 __attribute__((ext_vector_type(4)));
typedef unsigned u32x2 __attribute__((ext_vector_type(2)));
typedef float f32x2 __attribute__((ext_vector_type(2)));
typedef _Float16 h8 __attribute__((ext_vector_type(8)));
typedef _Float16 h4 __attribute__((ext_vector_type(4)));
typedef _Float16 h2 __attribute__((ext_vector_type(2)));
constexpr int NB = 16, SQ = 4096, DMODEL = 1024, TT = NB * SQ, DFF = 4096;
constexpr size_t MiB = 1u << 20;
constexpr size_t WS_LB = 0;
constexpr size_t WS_BAR = 65536, BAR_BYTES = 16384;
constexpr size_t WS_WIN = 1 * MiB, WS_WOUT = 9 * MiB, WS_WUP0 = 11 * MiB, WS_WUP1 = 19 * MiB, WS_WD0 = 27 * MiB, WS_WD1 = 35 * MiB,
                 WS_WBIG = 43 * MiB, WS_WLORA = 49 * MiB, WS_W2 = 56 * MiB, WS_WO = 57 * MiB;
constexpr size_t WS_LF = 60 * MiB, WS_CB = 62 * MiB, WS_SSK = 64 * MiB, WS_SS = 68 * MiB;
constexpr size_t WS_XN = 80 * MiB;
constexpr size_t WS_PROJ = 210 * MiB;
constexpr size_t WS_LH = 978 * MiB;
constexpr size_t WS_RKV = 594 * MiB;
constexpr size_t WS_WAG = 210 * MiB;
constexpr size_t WS_OA = 722 * MiB;
constexpr size_t WS_HB = 850 * MiB;
constexpr size_t WS_END = 1010 * MiB;
constexpr size_t PSTR = (size_t)TT * 512;
constexpr size_t RSTR = (size_t)TT * 1024;
constexpr int LDS_TOTAL = 147456;

typedef __bf16 bf16x2_k __attribute__((ext_vector_type(2)));
DI unsigned pk_bf16(float lo, float hi) { typedef float f2_ __attribute__((ext_vector_type(2))); const f2_ v = {lo, hi}; return __builtin_bit_cast(unsigned, __builtin_convertvector(v, bf16x2_k)); }
DI unsigned pk_f16(float lo, float hi) { h2 v = {(_Float16)lo, (_Float16)hi}; return __builtin_bit_cast(unsigned, v); }
DI float sigm(float x) { return __builtin_amdgcn_rcpf(1.0f + __expf(-x)); }
DI float bf2f(unsigned short b) { return __uint_as_float(((unsigned)b) << 16); }
template <int CTRL> DI float dpp_f(float x) { return __builtin_bit_cast(float, __builtin_amdgcn_update_dpp(0, __builtin_bit_cast(int, x), CTRL, 0xF, 0xF, true)); }
DI float red8(float x) { x += dpp_f<0xB1>(x); x += dpp_f<0x4E>(x); x += dpp_f<0x141>(x); return x; }
DI float red16(float x) { x = red8(x); x += dpp_f<0x140>(x); return x; }
DI float wave_sum(float v) {
#pragma unroll
    for (int o = 1; o < 64; o <<= 1) v += __shfl_xor(v, o);
    return v;
}
DI void st8_bf16(u16* p, const f32x4 a, const f32x4 b) { u32x4 w; w.x = pk_bf16(a[0], a[1]); w.y = pk_bf16(a[2], a[3]); w.z = pk_bf16(b[0], b[1]); w.w = pk_bf16(b[2], b[3]); *(u32x4*)p = w; }
DI void st8_bf16_nt(u16* p, const f32x4 a, const f32x4 b) { u32x4 w; w.x = pk_bf16(a[0], a[1]); w.y = pk_bf16(a[2], a[3]); w.z = pk_bf16(b[0], b[1]); w.w = pk_bf16(b[2], b[3]); __builtin_nontemporal_store(w, (u32x4*)p); }
DI void st8_f16(u16* p, const f32x4 a, const f32x4 b) { u32x4 w; w.x = pk_f16(a[0], a[1]); w.y = pk_f16(a[2], a[3]); w.z = pk_f16(b[0], b[1]); w.w = pk_f16(b[2], b[3]); *(u32x4*)p = w; }

struct EpiArgs { u16* o0; u16* o1; const float* p0; const float* p1; float* f0; float* ss; };
template <int MODE> struct Epi {
    static constexpr bool PERM = true, AFTER_DRAIN = false;
    EpiArgs a; const LAS float* rs = nullptr; mutable int ucnt = 0;
    DI void operator()(const f32x4 (&acc)[2][2][4][2], const pg8::Unit& u, int wr, int wc, int fr, int fq) const {
        const int rbase = u.pm * 256 + wr * 64 + fr;
        if constexpr (MODE == 0) {
            const int grp = u.pn >> 1, cg0 = (u.pn & 1) * 256 + wc * 32 + 8 * fq;
            u16* base = a.o0 + (size_t)grp * PSTR;
            if (grp == 5) {
                LAS float* xch = (LAS float*)rs;
                float ps[2][4][2];
#pragma unroll
                for (int ai = 0; ai < 2; ++ai)
#pragma unroll
                    for (int m = 0; m < 4; ++m)
#pragma unroll
                        for (int bj = 0; bj < 2; ++bj) { const f32x4 v0 = acc[ai][bj][m][0], v1 = acc[ai][bj][m][1];
                            float s = (v0[0] * v0[0] + v0[1] * v0[1]) + (v0[2] * v0[2] + v0[3] * v0[3]) + (v1[0] * v1[0] + v1[1] * v1[1]) + (v1[2] * v1[2] + v1[3] * v1[3]);
                            s += __shfl_xor(s, 16); s += __shfl_xor(s, 32); ps[ai][m][bj] = s;
                            if (fq == 0) xch[(ai * 128 + wr * 64 + m * 16 + fr) * 8 + bj * 4 + wc] = s; }
                asm volatile("s_waitcnt lgkmcnt(0)" ::: "memory"); __builtin_amdgcn_s_barrier(); asm volatile("" ::: "memory");
                const f32x4 gk0 = *(const f32x4*)(a.p1 + (wc & 1) * 32 + 8 * fq), gk1 = *(const f32x4*)(a.p1 + (wc & 1) * 32 + 8 * fq + 4);
#pragma unroll
                for (int ai = 0; ai < 2; ++ai)
#pragma unroll
                    for (int m = 0; m < 4; ++m) { const int row = rbase + ai * 128 + m * 16;
#pragma unroll
                        for (int bj = 0; bj < 2; ++bj) { const float tot = ps[ai][m][bj] + xch[(ai * 128 + wr * 64 + m * 16 + fr) * 8 + bj * 4 + (wc ^ 1)];
                            const float rstd = rsqrtf(tot * (1.0f / 64.0f) + 1e-6f);
                            st8_bf16(base + (size_t)row * 512 + cg0 + bj * 128, acc[ai][bj][m][0] * rstd * gk0, acc[ai][bj][m][1] * rstd * gk1); } }
                return;
            }
            f32x4 lb[2][2];
#pragma unroll
            for (int bj = 0; bj < 2; ++bj) { lb[bj][0] = *(const f32x4*)(a.p0 + cg0 + bj * 128); lb[bj][1] = *(const f32x4*)(a.p0 + cg0 + bj * 128 + 4); }
#pragma unroll
            for (int ai = 0; ai < 2; ++ai)
#pragma unroll
                for (int m = 0; m < 4; ++m) {
                    const int row = rbase + ai * 128 + m * 16;
#pragma unroll
                    for (int bj = 0; bj < 2; ++bj) {
                        f32x4 v0 = acc[ai][bj][m][0], v1 = acc[ai][bj][m][1];
                        u16* dst = base + (size_t)row * 512 + cg0 + bj * 128;
                        if (grp == 0 || grp == 3) {
#pragma unroll
                            for (int j = 0; j < 4; ++j) { v0[j] = v0[j] * sigm(v0[j]); v1[j] = v1[j] * sigm(v1[j]); }
                            st8_f16(dst, v0, v1);
                        } else if (grp == 1) {
#pragma unroll
                            for (int j = 0; j < 4; ++j) { v0[j] = lb[bj][0][j] + (1.0f - lb[bj][0][j]) * sigm(v0[j]); v1[j] = lb[bj][1][j] + (1.0f - lb[bj][1][j]) * sigm(v1[j]); }
                            st8_f16(dst, v0, v1);
                        } else if (grp == 2) { st8_f16(dst, v0, v1);
                        } else if (grp == 7) {
#pragma unroll
                            for (int j = 0; j < 4; ++j) { v0[j] = sigm(v0[j]); v1[j] = sigm(v1[j]); }
                            st8_f16(dst, v0, v1);
                        } else {
                            st8_bf16(dst, v0, v1);
                        }
                    }
                }
        } else if constexpr (MODE == 1) {
            const int col = u.pn * 256 + wc * 32 + 8 * fq;
#pragma unroll
            for (int ai = 0; ai < 2; ++ai)
#pragma unroll
                for (int m = 0; m < 4; ++m) {
                    const int row = rbase + ai * 128 + m * 16; float s = 0.f;
#pragma unroll
                    for (int bj = 0; bj < 2; ++bj) {
                        const size_t off = (size_t)row * 1024 + col + bj * 128;
                        f32x4 r0, r1;
                        if (a.p0) { r0 = *(const f32x4*)(a.p0 + off); r1 = *(const f32x4*)(a.p0 + off + 4); }
                        else { const u32x4 w = *(const u32x4*)(a.o1 + off);
                            r0[0] = __uint_as_float(w.x << 16); r0[1] = __uint_as_float(w.x & 0xffff0000u); r0[2] = __uint_as_float(w.y << 16); r0[3] = __uint_as_float(w.y & 0xffff0000u);
                            r1[0] = __uint_as_float(w.z << 16); r1[1] = __uint_as_float(w.z & 0xffff0000u); r1[2] = __uint_as_float(w.w << 16); r1[3] = __uint_as_float(w.w & 0xffff0000u); }
                        const f32x4 v0 = acc[ai][bj][m][0] + r0, v1 = acc[ai][bj][m][1] + r1;
                        if (a.f0) { *(f32x4*)(a.f0 + off) = v0; *(f32x4*)(a.f0 + off + 4) = v1; }
                        if (a.o0) st8_bf16(a.o0 + off, v0, v1);
                        s += (v0[0] * v0[0] + v0[1] * v0[1]) + (v0[2] * v0[2] + v0[3] * v0[3]) + (v1[0] * v1[0] + v1[1] * v1[1]) + (v1[2] * v1[2] + v1[3] * v1[3]);
                    }
                    if (a.ss) { s += __shfl_xor(s, 16); s += __shfl_xor(s, 32); if (fq == 0) a.ss[(size_t)row * 16 + u.pn * 4 + wc] = s; }
                }
        } else if constexpr (MODE == 2) {
            const int col = u.pn * 256 + wc * 32 + 8 * fq;
#pragma unroll
            for (int ai = 0; ai < 2; ++ai)
#pragma unroll
                for (int m = 0; m < 4; ++m) {
                    const int row = rbase + ai * 128 + m * 16;
                    const float rstd = rs[(ucnt & 1) * 256 + ai * 128 + wr * 64 + m * 16 + fr];
#pragma unroll
                    for (int bj = 0; bj < 2; ++bj) {
                        f32x4 v0 = acc[ai][bj][m][0], v1 = acc[ai][bj][m][1];
#pragma unroll
                        for (int j = 0; j < 4; ++j) { float t0 = fmaxf(v0[j], 0.f) * rstd, t1 = fmaxf(v1[j], 0.f) * rstd; v0[j] = t0 * t0; v1[j] = t1 * t1; }
                        st8_bf16(a.o0 + (size_t)row * 4096 + col + bj * 128, v0, v1);
                    }
                }
            ++ucnt;
        } else if constexpr (MODE == 3 || MODE == 5) {
#pragma unroll
            for (int ai = 0; ai < 2; ++ai)
#pragma unroll
                for (int m = 0; m < 4; ++m) {
                    const int row = rbase + ai * 128 + m * 16;
#pragma unroll
                    for (int bj = 0; bj < 2; ++bj) {
                        f32x4 v0 = acc[ai][bj][m][0], v1 = acc[ai][bj][m][1];
                        if (MODE == 3) { st8_f16(a.o0 + (size_t)(u.pn >> 2) * RSTR + (size_t)row * 1024 + (u.pn & 3) * 256 + bj * 128 + wc * 32 + 8 * fq, v0, v1); }
                        else {
                            if (bj == 1) {
#pragma unroll
                                for (int j = 0; j < 4; ++j) { v0[j] = sigm(v0[j]); v1[j] = sigm(v1[j]); }
                            } else if (wc < 2) {
#pragma unroll
                                for (int j = 0; j < 4; ++j) { v0[j] = 1.0f - 2.0f * __builtin_amdgcn_rcpf(__expf(2.0f * v0[j]) + 1.0f); v1[j] = 1.0f - 2.0f * __builtin_amdgcn_rcpf(__expf(2.0f * v1[j]) + 1.0f); }
                            }
                            st8_bf16(a.o1 + (size_t)row * 256 + bj * 128 + wc * 32 + 8 * fq, v0, v1);
                        }
                    }
                }
        } else if constexpr (MODE == 4) {
            const int grp = u.pn >> 2, c0 = (u.pn & 3) * 256 + wc * 32 + 8 * fq;
            const float* bias = grp == 0 ? a.p0 : a.p1;
#pragma unroll
            for (int ai = 0; ai < 2; ++ai)
#pragma unroll
                for (int m = 0; m < 4; ++m) {
                    const int row = rbase + ai * 128 + m * 16;
#pragma unroll
                    for (int bj = 0; bj < 2; ++bj) {
                        f32x4 bv[2][2]; bv[bj][0] = *(const f32x4*)(bias + c0 + bj * 128); bv[bj][1] = *(const f32x4*)(bias + c0 + bj * 128 + 4);
                        f32x4 v0 = acc[ai][bj][m][0], v1 = acc[ai][bj][m][1]; if (grp < 2) { v0 = v0 + bv[bj][0]; v1 = v1 + bv[bj][1]; }
                        asm volatile("" : "+v"(v0), "+v"(v1));
                        if (grp == 0) {
#pragma unroll
                            for (int j = 0; j < 4; ++j) { v0[j] = __expf(-0.60653066f * sigm(v0[j])); v1[j] = __expf(-0.60653066f * sigm(v1[j])); }
                        } else if (grp == 1) {
#pragma unroll
                            for (int j = 0; j < 4; ++j) { v0[j] = sigm(v0[j]); v1[j] = sigm(v1[j]); }
                        }
                        st8_f16(a.o0 + (size_t)grp * RSTR + (size_t)row * 1024 + c0 + bj * 128, v0, v1);
                    }
                }
        }
    }
};
DI void tr_item(const float* __restrict__ W, int ldw, int col0w, int Nn, u16* WT, int ldt, int row_off, int kcol_off, const float* __restrict__ sc, int scmode, LAS float* scr, int item, int lane) {
    const int nblk = Nn / 32, kb = item / nblk, nb = item % nblk, k0 = 64 * kb, n0 = 32 * nb;
#pragma unroll 8
    for (int i = 0; i < 32; ++i) { const int kk = 2 * i + (lane >> 5); float s = 1.0f; if (scmode == 1) s = sc[k0 + kk]; else if (scmode == 2) s = 1.0f - sc[k0 + kk];
        scr[kk * 33 + (lane & 31)] = W[(size_t)(k0 + kk) * ldw + col0w + n0 + (lane & 31)] * s; }
    asm volatile("s_waitcnt lgkmcnt(0)" ::: "memory");
    const int c = lane & 7;
#pragma unroll
    for (int j = 0; j < 4; ++j) { const int n = (lane >> 3) + 8 * j; const LAS float* s = scr + (8 * c) * 33 + n;
        u32x4 o; o.x = pk_bf16(s[0 * 33], s[1 * 33]); o.y = pk_bf16(s[2 * 33], s[3 * 33]); o.z = pk_bf16(s[4 * 33], s[5 * 33]); o.w = pk_bf16(s[6 * 33], s[7 * 33]);
        *(u32x4*)(WT + (size_t)(row_off + n0 + n) * ldt + kcol_off + k0 + 8 * c) = o; }
    asm volatile("s_waitcnt lgkmcnt(0)" ::: "memory");
}

struct Args { const float* in[28]; float* out; unsigned char* ws; };

DI void p0_prologue(const Args& A, LAS unsigned char* lds, int tid, int lane, int wave) {
    unsigned char* ws = A.ws;
    LAS float* scr = (LAS float*)(lds + wave * 16384);
    const int gw = blockIdx.x * 8 + wave, NGW = gridDim.x * 8;
    u16* WIN = (u16*)(ws + WS_WIN); u16* WOUT = (u16*)(ws + WS_WOUT); u16* WUP0 = (u16*)(ws + WS_WUP0); u16* WUP1 = (u16*)(ws + WS_WUP1);
    u16* WD0 = (u16*)(ws + WS_WD0); u16* WD1 = (u16*)(ws + WS_WD1); u16* WBIG = (u16*)(ws + WS_WBIG); u16* WLORA = (u16*)(ws + WS_WLORA); u16* W2 = (u16*)(ws + WS_W2); u16* WO = (u16*)(ws + WS_WO);
    const float* mu = A.in[10];
    constexpr int I_IN = 16 * 128, I_SQ = 16 * 32, I_UP = 16 * 128, I_DN = 64 * 32, I_L64 = 16 * 2, I_L128 = 16 * 4, I_W2 = 32, I_G2 = 64;
    constexpr int NITEMS = I_IN + I_SQ + 2 * I_UP + 2 * I_DN + 3 * I_SQ + 4 * I_L64 + 2 * I_L128 + 2 * I_W2 + I_G2 + I_SQ;
    for (int it = gw; it < NITEMS; it += NGW) {
        int r = it;
        if (r < I_IN) { tr_item(A.in[3], 4104, 0, 4096, WIN, 1024, 0, 0, nullptr, 0, scr, r, lane); continue; } r -= I_IN;
        if (r < I_SQ) { tr_item(A.in[9], 1024, 0, 1024, WOUT, 1024, 0, 0, nullptr, 0, scr, r, lane); continue; } r -= I_SQ;
        if (r < I_UP) { tr_item(A.in[26], 4096, 0, 4096, WUP0, 1024, 0, 0, A.in[2], 1, scr, r, lane); continue; } r -= I_UP;
        if (r < I_UP) { tr_item(A.in[26] + (size_t)1024 * 4096, 4096, 0, 4096, WUP1, 1024, 0, 0, A.in[2] + 1024, 1, scr, r, lane); continue; } r -= I_UP;
        if (r < I_DN) { tr_item(A.in[27], 1024, 0, 1024, WD0, 4096, 0, 0, nullptr, 0, scr, r, lane); continue; } r -= I_DN;
        if (r < I_DN) { tr_item(A.in[27] + (size_t)4096 * 1024, 1024, 0, 1024, WD1, 4096, 0, 0, nullptr, 0, scr, r, lane); continue; } r -= I_DN;
        if (r < 3 * I_SQ) { const int i3 = r / I_SQ;
            tr_item(A.in[11] + (size_t)i3 * 1024 * 1024, 1024, 0, 1024, WBIG, 1024, i3 * 1024, 0, nullptr, 0, scr, r % I_SQ, lane); continue; } r -= 3 * I_SQ;
        if (r < 2 * I_L64) { const int half = r / I_L64; tr_item(A.in[13], 64, 0, 64, WLORA, 2048, 0, half * 1024, mu + 1 * 1024, half ? 1 : 2, scr, r % I_L64, lane); continue; } r -= 2 * I_L64;
        if (r < 2 * I_L64) { const int half = r / I_L64; tr_item(A.in[16], 64, 0, 64, WLORA, 2048, 64, half * 1024, mu + 4 * 1024, half ? 1 : 2, scr, r % I_L64, lane); continue; } r -= 2 * I_L64;
        if (r < 2 * I_L128) { const int half = r / I_L128; tr_item(A.in[18], 128, 0, 128, WLORA, 2048, 128, half * 1024, mu + 5 * 1024, half ? 1 : 2, scr, r % I_L128, lane); continue; } r -= 2 * I_L128;
        if (r < I_W2) { tr_item(A.in[14], 1024, 0, 1024, W2, 128, 0, 0, nullptr, 0, scr, r, lane); continue; } r -= I_W2;
        if (r < I_W2) { tr_item(A.in[17], 1024, 0, 1024, W2, 128, 1024, 0, nullptr, 0, scr, r, lane); continue; } r -= I_W2;
        if (r < I_G2) { tr_item(A.in[19], 1024, 0, 1024, W2, 128, 2048, 0, nullptr, 0, scr, r, lane); continue; } r -= I_G2;
        tr_item(A.in[25], 1024, 0, 1024, WO, 1024, 0, 0, nullptr, 0, scr, r, lane);
    }
    for (int i = blockIdx.x * 512 + tid; i < 2048 * 8; i += gridDim.x * 512) { const int n = i >> 3, c = i & 7; *(u32x4*)(W2 + (size_t)n * 128 + 64 + c * 8) = (u32x4){0u, 0u, 0u, 0u}; }
    if (blockIdx.x == 0) { const float* G = A.in[4]; float* LB = (float*)(ws + WS_LB); const int c = tid;
        const float g0 = G[c], g1 = G[512 + c], g2 = G[1024 + c], mx = fmaxf(g0, fmaxf(g1, g2)); const float e0 = __expf(g0 - mx), e1 = __expf(g1 - mx), e2 = __expf(g2 - mx); LB[c] = e0 / (e0 + e1 + e2); }
    {
        const float* x = A.in[0]; const float* g = A.in[1]; const float* win = A.in[3]; const float* fb = A.in[6];
        u16* XN = (u16*)(ws + WS_XN); float* LF = (float*)(ws + WS_LF);
        f32x4 gv[4], wv0[4][4], wv1[4][4];
#pragma unroll
        for (int j = 0; j < 4; ++j) { gv[j] = *(const f32x4*)(g + 4 * lane + 256 * j);
#pragma unroll
            for (int e = 0; e < 4; ++e) { const float* wr_ = win + (size_t)(4 * lane + 256 * j + e) * 4104 + 4096; wv0[j][e] = *(const f32x4*)wr_; wv1[j][e] = *(const f32x4*)(wr_ + 4); } }
        asm volatile("" ::: "memory");
        for (int m = gw; m < TT; m += NGW) {
            const f32x4* xr = (const f32x4*)(x + (size_t)m * 1024) + lane;
            f32x4 v[4]; float s = 0.f;
#pragma unroll
            for (int j = 0; j < 4; ++j) { v[j] = xr[64 * j]; s += (v[j][0] * v[j][0] + v[j][1] * v[j][1]) + (v[j][2] * v[j][2] + v[j][3] * v[j][3]); }
            const float rstd = rsqrtf(wave_sum(s) * (1.0f / 1024.0f) + 1e-6f);
            float pf[8];
#pragma unroll
            for (int q = 0; q < 8; ++q) pf[q] = 0.f;
            u32x2* o8 = (u32x2*)(XN + (size_t)m * 1024) + lane;
#pragma unroll
            for (int j = 0; j < 4; ++j) { v[j] = v[j] * rstd * gv[j]; u32x2 w; w.x = pk_bf16(v[j][0], v[j][1]); w.y = pk_bf16(v[j][2], v[j][3]); o8[64 * j] = w;
#pragma unroll
                for (int e = 0; e < 4; ++e) { const f32x4 w0 = wv0[j][e], w1 = wv1[j][e];
                    pf[0] += v[j][e] * w0[0]; pf[1] += v[j][e] * w0[1]; pf[2] += v[j][e] * w0[2]; pf[3] += v[j][e] * w0[3]; pf[4] += v[j][e] * w1[0]; pf[5] += v[j][e] * w1[1]; pf[6] += v[j][e] * w1[2]; pf[7] += v[j][e] * w1[3]; } }
#pragma unroll
            for (int q = 0; q < 8; ++q) pf[q] = wave_sum(pf[q]);
            if (lane < 8) { float z = pf[0];
#pragma unroll
                for (int q = 1; q < 8; ++q) z = (lane == q) ? pf[q] : z;
                z += fb[lane]; LF[(size_t)m * 8 + lane] = fminf(z, 0.f) - log1pf(__expf(-fabsf(z))); }
        }
    }
}

DI void fox_cumsum(const Args& A, LAS unsigned char* lds, int bh, int tid, int lane, int wave) {
    const float* LF = (const float*)(A.ws + WS_LF); float* CB = (float*)(A.ws + WS_CB);
    const int b = bh >> 3, h = bh & 7; LAS float* tot = (LAS float*)lds;
    float v[8]; float run = 0.f;
#pragma unroll
    for (int i = 0; i < 8; ++i) { run += LF[((size_t)b * SQ + tid * 8 + i) * 8 + h]; v[i] = run; }
    float inc = run;
#pragma unroll
    for (int o = 1; o < 64; o <<= 1) { const float t = __shfl_up(inc, o); if (lane >= o) inc += t; }
    if (lane == 63) tot[wave] = inc;
    __syncthreads();
    float off = inc - run;
    for (int w = 0; w < wave; ++w) off += tot[w];
#pragma unroll
    for (int i = 0; i < 8; ++i) CB[(size_t)bh * SQ + tid * 8 + i] = -(v[i] + off) * 1.4426950408889634f;
    __syncthreads();
}

DI void hgrn_phase(const Args& A, LAS unsigned char* lds, int tid, int lane, int wave) {
    const int blk = blockIdx.x; if (blk >= 256) return;
    const int bh = blk >> 2, dq = blk & 3, b = bh >> 2, h = bh & 3;
    const _Float16* AQ = (const _Float16*)(A.ws + WS_PROJ); const _Float16* FF = AQ + PSTR; const _Float16* AI = AQ + 2 * PSTR;
    float* OA = (float*)(A.ws + WS_OA);
    LAS float* QL = (LAS float*)lds; LAS float* FL = QL + 64 * 128; LAS float* VL = FL + 64 * 128; LAS float* OL = VL + 64 * 32;
    const int dvl = lane >> 4, dkg = lane & 15, dvi = wave * 4 + dvl;
    const size_t row0 = (size_t)b * SQ;
    f32x2 S2[4];
#pragma unroll
    for (int i = 0; i < 4; ++i) S2[i] = (f32x2){0.f, 0.f};
    h8 pq[2], pf[2]; h4 pv;
    const int e0 = tid * 8;
    const int vt = tid >> 3, vo = (tid & 7) * 4;
#define HG_LOAD(c) do { _Pragma("unroll") for (int i = 0; i < 2; ++i) { const int e = e0 + i * 4096, t = e >> 7, dk = e & 127; const size_t g = (row0 + (size_t)(c) * 64 + t) * 512 + h * 128 + dk; pq[i] = *(const h8*)(AQ + g); pf[i] = *(const h8*)(FF + g); } \
        pv = *(const h4*)(AI + (row0 + (size_t)(c) * 64 + vt) * 512 + h * 128 + dq * 32 + vo); } while (0)
    HG_LOAD(0);
    for (int c = 0; c < 64; ++c) {
        __syncthreads();
#pragma unroll
        for (int i = 0; i < 2; ++i) { const int e = e0 + i * 4096;
            f32x4 a0, a1, b0, b1;
#pragma unroll
            for (int j = 0; j < 4; ++j) { a0[j] = (float)pq[i][j]; a1[j] = (float)pq[i][4 + j]; b0[j] = (float)pf[i][j]; b1[j] = (float)pf[i][4 + j]; }
            *(LAS f32x4*)(QL + e) = a0; *(LAS f32x4*)(QL + e + 4) = a1; *(LAS f32x4*)(FL + e) = b0; *(LAS f32x4*)(FL + e + 4) = b1; }
        { f32x4 vv; vv[0] = (float)pv[0]; vv[1] = (float)pv[1]; vv[2] = (float)pv[2]; vv[3] = (float)pv[3]; *(LAS f32x4*)(VL + vt * 32 + vo) = vv; }
        __syncthreads();
        if (c + 1 < 64) HG_LOAD(c + 1);
        f32x4 nf0 = *(const LAS f32x4*)(FL + dkg * 8), nf1 = *(const LAS f32x4*)(FL + dkg * 8 + 4), nq0 = *(const LAS f32x4*)(QL + dkg * 8), nq1 = *(const LAS f32x4*)(QL + dkg * 8 + 4);
        float nvv = VL[dvi];
#pragma unroll 4
        for (int t = 0; t < 64; ++t) {
            const f32x4 f0 = nf0, f1 = nf1, q0 = nq0, q1 = nq1; const float vv = nvv;
            { const int o = ((t + 1) & 63) * 128 + dkg * 8;
              nf0 = *(const LAS f32x4*)(FL + o); nf1 = *(const LAS f32x4*)(FL + o + 4); nq0 = *(const LAS f32x4*)(QL + o); nq1 = *(const LAS f32x4*)(QL + o + 4); nvv = VL[((t + 1) & 63) * 32 + dvi]; }
            const f32x2 v2 = {vv, vv};
            S2[0] = (f32x2){f0[0], f0[1]} * (S2[0] - v2) + v2; S2[1] = (f32x2){f0[2], f0[3]} * (S2[1] - v2) + v2;
            S2[2] = (f32x2){f1[0], f1[1]} * (S2[2] - v2) + v2; S2[3] = (f32x2){f1[2], f1[3]} * (S2[3] - v2) + v2;
            f32x2 op = S2[0] * (f32x2){q0[0], q0[1]} + S2[1] * (f32x2){q0[2], q0[3]}; op = op + (S2[2] * (f32x2){q1[0], q1[1]} + S2[3] * (f32x2){q1[2], q1[3]});
            const float o = red16(op.x + op.y);
            if (dkg == 0) OL[t * 32 + dvi] = o;
        }
        __syncthreads();
        { const f32x4 ov = *(const LAS f32x4*)(OL + vt * 32 + vo); *(f32x4*)(OA + (row0 + (size_t)c * 64 + vt) * 512 + h * 128 + dq * 32 + vo) = ov; }
    }
#undef HG_LOAD
    __syncthreads();
}

DI u16 f2bf(float f) { const unsigned u = __float_as_uint(f); return (u16)((u + 0x7fffu + ((u >> 16) & 1u)) >> 16); }
DI void hgrn_mfma_phase(const Args& A, LAS unsigned char* lds, int tid, int lane, int wave) {
    typedef short bfx8 __attribute__((ext_vector_type(8)));
    const int bh = blockIdx.x >> 1, half = blockIdx.x & 1, b = bh >> 2, h = bh & 3;
    const _Float16* AQ = (const _Float16*)(A.ws + WS_PROJ); const _Float16* FF = AQ + PSTR; const _Float16* AI = AQ + 2 * PSTR;
    float* OA = (float*)(A.ws + WS_OA);
    LAS _Float16* QH = (LAS _Float16*)lds; LAS _Float16* FH = QH + 64 * 128; LAS u16* AS = (LAS u16*)lds;
    LAS u16* Qt = (LAS u16*)(lds + 32768); LAS u16* Kt = Qt + 64 * 136; LAS u16* KhT = Kt + 64 * 136; LAS u16* VT = KhT + 128 * 72; LAS u16* ST = VT + 128 * 72;
    LAS float* EBL = (LAS float*)(ST + 128 * 136); LAS float* SEG = EBL + 128; LAS float* NS = SEG + 512;
    const size_t row0 = (size_t)b * SQ;
    const int l16 = lane & 15, lq = lane >> 4;
    const _Float16* AGp = (const _Float16*)(A.ws + WS_PROJ) + 3 * PSTR; u16* Y = (u16*)(A.ws + WS_XN);
    f32x4 gnv[4]; h4 pg[4];
#pragma unroll
    for (int j = 0; j < 4; ++j) gnv[j] = *(const f32x4*)(A.in[5] + h * 128 + 16 * ((wave & 1) * 4 + j) + 4 * lq);
    for (int i = tid; i < 128 * 136 / 2; i += 512) ((LAS unsigned*)ST)[i] = 0u;
    f32x4 Sacc[8];
#pragma unroll
    for (int j = 0; j < 8; ++j) Sacc[j] = (f32x4){0.f, 0.f, 0.f, 0.f};
    h8 pq[2], pf[2], pv[2];
    const int e0 = tid * 8;
    const int cd = tid & 127, tq = tid >> 7;
#define HG_LOAD(c) do { _Pragma("unroll") for (int i = 0; i < 2; ++i) { const int e = e0 + i * 4096, t = e >> 7, dk = e & 127; const size_t g = (row0 + (size_t)(c) * 64 + t) * 512 + h * 128 + dk; pq[i] = *(const h8*)(AQ + g); pf[i] = *(const h8*)(FF + g); pv[i] = *(const h8*)(AI + g); } } while (0)
    const int c_out = half ? 32 : 0, c_end = half ? 64 : 32; int cs = c_out;
    if (half) {
        float accd = 1.0f;
        while (cs > 0) {
            const int j = cs - 1;
#pragma unroll
            for (int i = 0; i < 2; ++i) { const int e = e0 + i * 4096, t = e >> 7, dk = e & 127; *(LAS h8*)(FH + e) = *(const h8*)(FF + (row0 + (size_t)j * 64 + t) * 512 + h * 128 + dk); }
            __syncthreads();
            float run = 1.0f;
#pragma unroll
            for (int i = 0; i < 16; ++i) run *= (float)FH[(16 * tq + i) * 128 + cd];
            SEG[tq * 128 + cd] = run;
            __syncthreads();
            accd *= (SEG[cd] * SEG[128 + cd]) * (SEG[256 + cd] * SEG[384 + cd]);
            float m = accd;
#pragma unroll
            for (int o_ = 1; o_ < 64; o_ <<= 1) m = fmaxf(m, __shfl_xor(m, o_));
            if (lane == 0) NS[wave] = m;
            __syncthreads();
            float mx = NS[0];
#pragma unroll
            for (int w_ = 1; w_ < 8; ++w_) mx = fmaxf(mx, NS[w_]);
            cs = j;
            __syncthreads();
            if (mx < 2.8e-14f) break;
        }
    }
    HG_LOAD(cs);
    for (int c = cs; c < c_end; ++c) {
        const bool emit = (c >= c_out);
#pragma unroll
        for (int i = 0; i < 2; ++i) { const int e = e0 + i * 4096, t = e >> 7, dv = e & 127; *(LAS h8*)(QH + e) = pq[i]; *(LAS h8*)(FH + e) = pf[i];
#pragma unroll
            for (int j = 0; j < 8; j += 2) { const unsigned vw = pk_bf16((float)pv[i][j], (float)pv[i][j + 1]); VT[(dv + j) * 72 + t] = (u16)vw; VT[(dv + j + 1) * 72 + t] = (u16)(vw >> 16); } }
        __syncthreads();
        if (c + 1 < c_end) HG_LOAD(c + 1);
#pragma unroll
        for (int j = 0; j < 4; ++j) pg[j] = *(const h4*)(AGp + (row0 + (size_t)c * 64 + 16 * (wave >> 1) + l16) * 512 + h * 128 + 16 * ((wave & 1) * 4 + j) + 4 * lq);
        float cs[16], kq[16]; float run = 1.0f;
#pragma unroll
        for (int i = 0; i < 16; ++i) { const float f = (float)FH[(16 * tq + i) * 128 + cd]; kq[i] = 1.0f - f; run *= f; cs[i] = run; }
        SEG[tq * 128 + cd] = run;
        __syncthreads();
        { const float s0 = SEG[cd], s1 = SEG[128 + cd], s2 = SEG[256 + cd], s3 = SEG[384 + cd];
          const float off = (tq > 0 ? s0 : 1.0f) * (tq > 1 ? s1 : 1.0f) * (tq > 2 ? s2 : 1.0f), ebl = (s0 * s1) * (s2 * s3);
          unsigned khw[8];
#pragma unroll
          for (int i = 0; i < 16; i += 2) { const int t = 16 * tq + i; const float q0 = (float)QH[t * 128 + cd], q1 = (float)QH[(t + 1) * 128 + cd];
              const float x0 = cs[i] * off, x1 = cs[i + 1] * off, k0 = kq[i] * __builtin_amdgcn_rcpf(x0), k1 = kq[i + 1] * __builtin_amdgcn_rcpf(x1);
              const unsigned qw = pk_bf16(q0 * x0, q1 * x1), kw = pk_bf16(k0, k1);
              Qt[t * 136 + cd] = (u16)qw; Qt[(t + 1) * 136 + cd] = (u16)(qw >> 16); Kt[t * 136 + cd] = (u16)kw; Kt[(t + 1) * 136 + cd] = (u16)(kw >> 16);
              khw[i >> 1] = pk_bf16(k0 * ebl, k1 * ebl); }
          if (tq == 0) EBL[cd] = ebl;
          *(LAS u32x4*)(KhT + cd * 72 + 16 * tq) = (u32x4){khw[0], khw[1], khw[2], khw[3]}; *(LAS u32x4*)(KhT + cd * 72 + 16 * tq + 8) = (u32x4){khw[4], khw[5], khw[6], khw[7]}; }
        __syncthreads();
        { const int tt = wave >> 1;
#pragma unroll
          for (int j = 0; j < 2; ++j) { const int st = (wave & 1) * 2 + j; f32x4 acc = (f32x4){0.f, 0.f, 0.f, 0.f};
              if (st <= tt) {
#pragma unroll
                  for (int kk = 0; kk < 4; ++kk) { const bfx8 X = *(const LAS bfx8*)(Kt + (16 * st + l16) * 136 + 32 * kk + 8 * lq), Y = *(const LAS bfx8*)(Qt + (16 * tt + l16) * 136 + 32 * kk + 8 * lq);
                      acc = __builtin_amdgcn_mfma_f32_16x16x32_bf16(X, Y, acc, 0, 0, 0); } }
              const int t = 16 * tt + l16, s = 16 * st + 4 * lq; u32x2 w;
              w.x = pk_bf16(s + 0 <= t ? acc[0] : 0.f, s + 1 <= t ? acc[1] : 0.f); w.y = pk_bf16(s + 2 <= t ? acc[2] : 0.f, s + 3 <= t ? acc[3] : 0.f);
              *(LAS u32x2*)(AS + t * 72 + s) = w; } }
        __syncthreads();
        f32x4 oacc[4];
        { const int tt = wave >> 1; bfx8 ya[2], yq[4];
#pragma unroll
          for (int kk = 0; kk < 2; ++kk) ya[kk] = *(const LAS bfx8*)(AS + (16 * tt + l16) * 72 + 32 * kk + 8 * lq);
#pragma unroll
          for (int kk = 0; kk < 4; ++kk) yq[kk] = *(const LAS bfx8*)(Qt + (16 * tt + l16) * 136 + 32 * kk + 8 * lq);
#pragma unroll
          for (int j = 0; j < 4; ++j) { const int vt = (wave & 1) * 4 + j; f32x4 acc = (f32x4){0.f, 0.f, 0.f, 0.f};
#pragma unroll
              for (int kk = 0; kk < 2; ++kk) acc = __builtin_amdgcn_mfma_f32_16x16x32_bf16(*(const LAS bfx8*)(VT + (16 * vt + l16) * 72 + 32 * kk + 8 * lq), ya[kk], acc, 0, 0, 0);
#pragma unroll
              for (int kk = 0; kk < 4; ++kk) acc = __builtin_amdgcn_mfma_f32_16x16x32_bf16(*(const LAS bfx8*)(ST + (16 * vt + l16) * 136 + 32 * kk + 8 * lq), yq[kk], acc, 0, 0, 0);
              oacc[j] = acc; }
          { float s_ = 0.f;
#pragma unroll
            for (int j = 0; j < 4; ++j) s_ += (oacc[j][0] * oacc[j][0] + oacc[j][1] * oacc[j][1]) + (oacc[j][2] * oacc[j][2] + oacc[j][3] * oacc[j][3]);
            s_ += __shfl_xor(s_, 16); s_ += __shfl_xor(s_, 32);
            if (lq == 0) NS[(16 * tt + l16) * 2 + (wave & 1)] = s_; }
          const bfx8 xv0 = *(const LAS bfx8*)(VT + (16 * wave + l16) * 72 + 8 * lq), xv1 = *(const LAS bfx8*)(VT + (16 * wave + l16) * 72 + 32 + 8 * lq);
#pragma unroll
          for (int dt = 0; dt < 8; ++dt) { const float dec = EBL[16 * dt + l16]; f32x4 sa = Sacc[dt] * dec;
              sa = __builtin_amdgcn_mfma_f32_16x16x32_bf16(xv0, *(const LAS bfx8*)(KhT + (16 * dt + l16) * 72 + 8 * lq), sa, 0, 0, 0);
              sa = __builtin_amdgcn_mfma_f32_16x16x32_bf16(xv1, *(const LAS bfx8*)(KhT + (16 * dt + l16) * 72 + 32 + 8 * lq), sa, 0, 0, 0);
              Sacc[dt] = sa; } }
        __syncthreads();
        { const int tt = wave >> 1; const float rstd = rsqrtf((NS[(16 * tt + l16) * 2] + NS[(16 * tt + l16) * 2 + 1]) * (1.0f / 128.0f) + 1e-6f);
          const size_t grow = row0 + (size_t)c * 64 + 16 * tt + l16;
          if (emit)
#pragma unroll
          for (int j = 0; j < 4; ++j) { const int vcol = h * 128 + 16 * ((wave & 1) * 4 + j) + 4 * lq; const h4 gt = pg[j];
              u32x2 w_; w_.x = pk_bf16(oacc[j][0] * rstd * gnv[j][0] * (float)gt[0], oacc[j][1] * rstd * gnv[j][1] * (float)gt[1]); w_.y = pk_bf16(oacc[j][2] * rstd * gnv[j][2] * (float)gt[2], oacc[j][3] * rstd * gnv[j][3] * (float)gt[3]);
              *(u32x2*)(Y + grow * 1024 + vcol) = w_; } }
#pragma unroll
        for (int dt = 0; dt < 8; ++dt)
#pragma unroll
            for (int r = 0; r < 4; r += 2) { const unsigned sw = pk_bf16(Sacc[dt][r], Sacc[dt][r + 1]); ST[(16 * wave + 4 * lq + r) * 136 + 16 * dt + l16] = (u16)sw; ST[(16 * wave + 4 * lq + r + 1) * 136 + 16 * dt + l16] = (u16)(sw >> 16); }
    }
#undef HG_LOAD
    __syncthreads();
}

DI void hgrn_norm_phase(const Args& A, int lane, int wave) {
    const float* OA = (const float*)(A.ws + WS_OA); const _Float16* AG = (const _Float16*)(A.ws + WS_PROJ) + 3 * PSTR; const float* gn = A.in[5];
    u16* Y = (u16*)(A.ws + WS_XN);
    const int gw = blockIdx.x * 8 + wave, NGW = gridDim.x * 8, c0 = lane * 8;
    const f32x4 g0 = *(const f32x4*)(gn + c0), g1 = *(const f32x4*)(gn + c0 + 4);
    for (int m = gw; m < TT; m += NGW) {
        f32x4 v0 = *(const f32x4*)(OA + (size_t)m * 512 + c0), v1 = *(const f32x4*)(OA + (size_t)m * 512 + c0 + 4);
        const h8 gg = *(const h8*)(AG + (size_t)m * 512 + c0);
        float s = (v0[0] * v0[0] + v0[1] * v0[1]) + (v0[2] * v0[2] + v0[3] * v0[3]) + (v1[0] * v1[0] + v1[1] * v1[1]) + (v1[2] * v1[2] + v1[3] * v1[3]);
        s = red16(s);
        const float rstd = rsqrtf(s * (1.0f / 128.0f) + 1e-6f);
#pragma unroll
        for (int j = 0; j < 4; ++j) { v0[j] = v0[j] * rstd * g0[j] * (float)gg[j]; v1[j] = v1[j] * rstd * g1[j] * (float)gg[4 + j]; }
        st8_bf16(Y + (size_t)m * 1024 + c0, v0, v1);
    }
}

DI void knorm_phase(const Args& A, int lane, int wave) {
    u16* BK = (u16*)(A.ws + WS_PROJ) + 5 * PSTR; const float* gk = A.in[8];
    const int gw = blockIdx.x * 8 + wave, NGW = gridDim.x * 8, c0 = lane * 8;
    const f32x4 g0 = *(const f32x4*)(gk + (c0 & 63)), g1 = *(const f32x4*)(gk + (c0 & 63) + 4);
    for (int m = gw; m < TT; m += NGW) {
        const u32x4 w = *(const u32x4*)(BK + (size_t)m * 512 + c0);
        f32x4 v0, v1;
        v0[0] = __uint_as_float(w.x << 16); v0[1] = __uint_as_float(w.x & 0xffff0000u); v0[2] = __uint_as_float(w.y << 16); v0[3] = __uint_as_float(w.y & 0xffff0000u);
        v1[0] = __uint_as_float(w.z << 16); v1[1] = __uint_as_float(w.z & 0xffff0000u); v1[2] = __uint_as_float(w.w << 16); v1[3] = __uint_as_float(w.w & 0xffff0000u);
        float s = (v0[0] * v0[0] + v0[1] * v0[1]) + (v0[2] * v0[2] + v0[3] * v0[3]) + (v1[0] * v1[0] + v1[1] * v1[1]) + (v1[2] * v1[2] + v1[3] * v1[3]);
        s = red8(s);
        const float rstd = rsqrtf(s * (1.0f / 64.0f) + 1e-6f);
        v0 = v0 * rstd * g0; v1 = v1 * rstd * g1;
        st8_bf16(BK + (size_t)m * 512 + c0, v0, v1);
    }
}

DI void norm1_phase(const Args& A, int lane, int wave) {
    const u16* hsrc = (const u16*)A.out; const float* g = A.in[1] + 1024; const float* mu = A.in[10]; u16* XN = (u16*)(A.ws + WS_XN); u16* MX = (u16*)(A.ws + WS_PROJ);
    const int gw = blockIdx.x * 8 + wave, NGW = gridDim.x * 8;
    if (gw < NB) { u32x2* o8 = (u32x2*)(XN + (size_t)gw * 4097 * 1024) + lane;
#pragma unroll
        for (int j = 0; j < 4; ++j) o8[64 * j] = (u32x2){0u, 0u}; }
    f32x4 gv[4], mu0[4], mu2[4], mu3[4];
#pragma unroll
    for (int j = 0; j < 4; ++j) { const int c = 4 * lane + 256 * j; gv[j] = *(const f32x4*)(g + c); mu0[j] = *(const f32x4*)(mu + c); mu2[j] = *(const f32x4*)(mu + 2 * 1024 + c); mu3[j] = *(const f32x4*)(mu + 3 * 1024 + c); }
    asm volatile("" ::: "memory");
    const int rows_per = TT / NGW;
    const int m0 = gw * rows_per;
    f32x4 prev[4];
    if ((m0 & 4095) == 0) {
#pragma unroll
        for (int j = 0; j < 4; ++j) prev[j] = (f32x4){0.f, 0.f, 0.f, 0.f};
    } else {
        const u32x2* xr = (const u32x2*)(hsrc + (size_t)(m0 - 1) * 1024) + lane; float s = 0.f;
#pragma unroll
        for (int j = 0; j < 4; ++j) { const u32x2 w_ = xr[64 * j]; prev[j] = (f32x4){__uint_as_float(w_.x << 16), __uint_as_float(w_.x & 0xffff0000u), __uint_as_float(w_.y << 16), __uint_as_float(w_.y & 0xffff0000u)}; s += (prev[j][0] * prev[j][0] + prev[j][1] * prev[j][1]) + (prev[j][2] * prev[j][2] + prev[j][3] * prev[j][3]); }
        const float rstd = rsqrtf(wave_sum(s) * (1.0f / 1024.0f) + 1e-6f);
#pragma unroll
        for (int j = 0; j < 4; ++j) prev[j] = prev[j] * rstd * gv[j];
    }
    for (int m = m0; m < m0 + rows_per; ++m) {
        const u32x2* xr = (const u32x2*)(hsrc + (size_t)m * 1024) + lane;
        f32x4 v[4]; float s = 0.f;
#pragma unroll
        for (int j = 0; j < 4; ++j) { const u32x2 w_ = xr[64 * j]; v[j] = (f32x4){__uint_as_float(w_.x << 16), __uint_as_float(w_.x & 0xffff0000u), __uint_as_float(w_.y << 16), __uint_as_float(w_.y & 0xffff0000u)}; s += (v[j][0] * v[j][0] + v[j][1] * v[j][1]) + (v[j][2] * v[j][2] + v[j][3] * v[j][3]); }
        const float rstd = rsqrtf(wave_sum(s) * (1.0f / 1024.0f) + 1e-6f);
        if ((m & 4095) == 0) {
#pragma unroll
            for (int j = 0; j < 4; ++j) prev[j] = (f32x4){0.f, 0.f, 0.f, 0.f};
        }
        const size_t prow = (size_t)(m >> 12) * 4097 + 1 + (m & 4095);
        u32x2* o8 = (u32x2*)(XN + prow * 1024) + lane;
        u32x2* o0 = (u32x2*)(MX + (size_t)m * 1024) + lane; u32x2* o1 = (u32x2*)(MX + RSTR + (size_t)m * 1024) + lane; u32x2* o2 = (u32x2*)(MX + 2 * RSTR + (size_t)m * 1024) + lane;
#pragma unroll
        for (int j = 0; j < 4; ++j) {
            v[j] = v[j] * rstd * gv[j];
            const f32x4 xx = prev[j] - v[j];
            u32x2 w; w.x = pk_bf16(v[j][0], v[j][1]); w.y = pk_bf16(v[j][2], v[j][3]); o8[64 * j] = w;
            f32x4 t = v[j] + xx * mu0[j];            w.x = pk_bf16(t[0], t[1]); w.y = pk_bf16(t[2], t[3]); o0[64 * j] = w;
            t = v[j] + xx * mu2[j];       w.x = pk_bf16(t[0], t[1]); w.y = pk_bf16(t[2], t[3]); o1[64 * j] = w;
            t = v[j] + xx * mu3[j];       w.x = pk_bf16(t[0], t[1]); w.y = pk_bf16(t[2], t[3]); o2[64 * j] = w;
            prev[j] = v[j];
        }
    }
}

DI void wkv_phase(const Args& A, LAS unsigned char* lds, int tid, int lane, int wave) {
    typedef short bfx8 __attribute__((ext_vector_type(8)));
    const int blk = blockIdx.x; if (blk >= 256) return;
    const int b = blk >> 4, hh = blk & 15;
    const _Float16* R = (const _Float16*)(A.ws + WS_RKV); const _Float16* KR = R + RSTR; const _Float16* V = R + 2 * RSTR;
    const u16* LH = (const u16*)(A.ws + WS_LH); const u16* W2 = (const u16*)(A.ws + WS_W2);
    u16* Z = (u16*)(A.ws + WS_XN);
    constexpr int CH = 32;
    LAS float* Lw = (LAS float*)lds; LAS float* La = Lw + CH * 64; LAS float* Lb = La + CH * 64; LAS float* Lk = Lb + CH * 64; LAS float* Lr = Lk + CH * 64; LAS float* Lv = Lr + CH * 64;
    LAS float* Ly = Lv + CH * 64; LAS float* Lbon = Ly + CH * 256;
    LAS float* Lga = Lbon + 64; LAS float* Lgg = Lga + CH * 64;
    const int pt = tid >> 4, pi = (tid & 15) * 4;
    const int ch = hh * 64 + pi;
    const f32x4 c_kk = *(const f32x4*)(A.in[20] + ch), c_ka = *(const f32x4*)(A.in[21] + ch), c_rk = *(const f32x4*)(A.in[22] + ch), c_lg = *(const f32x4*)(A.in[23] + ch), c_lb = *(const f32x4*)(A.in[24] + ch);
    const int v0 = wave * 8 + (lane >> 4) * 2, k0 = (lane & 15) * 4;
    const size_t row0 = (size_t)b * SQ;
    const int l16 = lane & 15, lq = lane >> 4, ct = wave >> 1, tt = wave & 1;
    bfx8 xw[2], xa[2], xg[4];
    { const u16* wp = W2 + (size_t)(hh * 64 + 16 * ct + l16) * 128 + 8 * lq;
#pragma unroll
      for (int kk = 0; kk < 2; ++kk) { xw[kk] = *(const bfx8*)(wp + 32 * kk); xa[kk] = *(const bfx8*)(wp + (size_t)1024 * 128 + 32 * kk); }
#pragma unroll
      for (int kk = 0; kk < 4; ++kk) xg[kk] = *(const bfx8*)(wp + (size_t)2048 * 128 + 32 * kk); }
    const int mch = 16 * ct + l16;
    const float bw0 = A.in[12][hh * 64 + mch], ba0 = A.in[15][hh * 64 + mch];
    f32x2 S0a = {0.f, 0.f}, S0b = {0.f, 0.f}, S1a = {0.f, 0.f}, S1b = {0.f, 0.f};
    h4 xr, xk, xv; f32x4 g_cur; bfx8 yl[8];
#define WK_LOAD(c) do { const size_t g = (row0 + (size_t)(c) * CH + pt) * 1024 + ch; xr = *(const h4*)(R + g); xk = *(const h4*)(KR + g); xv = *(const h4*)(V + g); \
        const u16* lp_ = LH + (row0 + (size_t)(c) * CH + 16 * tt + l16) * 256 + 8 * lq; \
        _Pragma("unroll") for (int kk = 0; kk < 2; ++kk) { yl[kk] = *(const bfx8*)(lp_ + 32 * kk); yl[2 + kk] = *(const bfx8*)(lp_ + 64 + 32 * kk); } \
        _Pragma("unroll") for (int kk = 0; kk < 4; ++kk) yl[4 + kk] = *(const bfx8*)(lp_ + 128 + 32 * kk); } while (0)
#define WK_LORA() do { f32x4 dw = {0.f, 0.f, 0.f, 0.f}, da = {0.f, 0.f, 0.f, 0.f}, dg = {0.f, 0.f, 0.f, 0.f}; \
        _Pragma("unroll") for (int kk = 0; kk < 2; ++kk) { dw = __builtin_amdgcn_mfma_f32_16x16x32_bf16(yl[kk], xw[kk], dw, 0, 0, 0); da = __builtin_amdgcn_mfma_f32_16x16x32_bf16(yl[2 + kk], xa[kk], da, 0, 0, 0); } \
        _Pragma("unroll") for (int kk = 0; kk < 4; ++kk) dg = __builtin_amdgcn_mfma_f32_16x16x32_bf16(yl[4 + kk], xg[kk], dg, 0, 0, 0); \
        _Pragma("unroll") for (int j = 0; j < 4; ++j) { dw[j] = __expf(-0.60653066f * sigm(dw[j] + bw0)); da[j] = sigm(da[j] + ba0); \
            const int o_ = (16 * tt + 4 * lq + j) * 64 + mch; Lw[o_] = dw[j]; Lga[o_] = da[j]; Lgg[o_] = dg[j]; } } while (0)
    WK_LOAD(0);
    WK_LORA();
    constexpr int NCH = SQ / CH;
    for (int c = 0; c < NCH; ++c) {
        __syncthreads();
        {
            f32x4 r4, k4, v4, kk, kx, an, bn;
            const f32x4 a4 = *(const LAS f32x4*)(Lga + pt * 64 + pi); g_cur = *(const LAS f32x4*)(Lgg + pt * 64 + pi);
#pragma unroll
            for (int j = 0; j < 4; ++j) { r4[j] = (float)xr[j]; k4[j] = (float)xk[j]; v4[j] = (float)xv[j]; }
            kk = k4 * c_kk;
            float ssq = (kk[0] * kk[0] + kk[1] * kk[1]) + (kk[2] * kk[2] + kk[3] * kk[3]); ssq = red16(ssq);
            const float inv = rsqrtf(fmaxf(ssq, 1e-24f));
            float bon = 0.f;
#pragma unroll
            for (int j = 0; j < 4; ++j) { const float kn = kk[j] * inv; kx[j] = k4[j] * (1.0f + (a4[j] - 1.0f) * c_ka[j]); an[j] = -kn; bn[j] = kn * a4[j]; bon += r4[j] * kx[j] * c_rk[j]; }
            bon = red16(bon);
            const int o = pt * 64 + pi;
            *(LAS f32x4*)(La + o) = an; *(LAS f32x4*)(Lb + o) = bn; *(LAS f32x4*)(Lk + o) = kx; *(LAS f32x4*)(Lr + o) = r4; *(LAS f32x4*)(Lv + o) = v4;
            if ((tid & 15) == 0) Lbon[pt] = bon;
        }
        __syncthreads();
        if (c + 1 < NCH) WK_LOAD(c + 1);
        f32x4 na4 = *(const LAS f32x4*)(La + k0), nw4 = *(const LAS f32x4*)(Lw + k0), nb4 = *(const LAS f32x4*)(Lb + k0), nk4 = *(const LAS f32x4*)(Lk + k0), nr4 = *(const LAS f32x4*)(Lr + k0);
        f32x2 nvv = *(const LAS f32x2*)(Lv + v0);
#pragma unroll 4
        for (int t = 0; t < CH; ++t) {
            const f32x4 a4 = na4, w4 = nw4, b4 = nb4, k4 = nk4, r4 = nr4; const f32x2 vv = nvv;
            { const int o = (t + 1) * 64 + k0;
              na4 = *(const LAS f32x4*)(La + o); nw4 = *(const LAS f32x4*)(Lw + o); nb4 = *(const LAS f32x4*)(Lb + o); nk4 = *(const LAS f32x4*)(Lk + o); nr4 = *(const LAS f32x4*)(Lr + o);
              nvv = *(const LAS f32x2*)(Lv + (t + 1) * 64 + v0); }
            const f32x2 alo = {a4[0], a4[1]}, ahi = {a4[2], a4[3]}, wlo = {w4[0], w4[1]}, whi = {w4[2], w4[3]}, blo = {b4[0], b4[1]}, bhi = {b4[2], b4[3]}, klo = {k4[0], k4[1]}, khi = {k4[2], k4[3]}, rlo = {r4[0], r4[1]}, rhi = {r4[2], r4[3]};
            f32x2 p0 = S0a * alo + S0b * ahi, p1 = S1a * alo + S1b * ahi;
            const float sa0 = red16(p0.x + p0.y), sa1 = red16(p1.x + p1.y);
            const f32x2 sa0v = {sa0, sa0}, sa1v = {sa1, sa1}, v0v = {vv.x, vv.x}, v1v = {vv.y, vv.y};
            S0a = S0a * wlo + (sa0v * blo + v0v * klo); S0b = S0b * whi + (sa0v * bhi + v0v * khi);
            S1a = S1a * wlo + (sa1v * blo + v1v * klo); S1b = S1b * whi + (sa1v * bhi + v1v * khi);
            p0 = S0a * rlo + S0b * rhi; p1 = S1a * rlo + S1b * rhi;
            float y0 = p0.x + p0.y, y1 = p1.x + p1.y;
            y0 += dpp_f<0xB1>(y0); y1 += dpp_f<0xB1>(y1); y0 += dpp_f<0x4E>(y0); y1 += dpp_f<0x4E>(y1);
            if ((lane & 3) == 0) *(LAS f32x2*)(Ly + t * 256 + ((lane & 15) >> 2) * 64 + v0) = (f32x2){y0, y1};
        }
        __syncthreads();
        {
            const int o = pt * 64 + pi;
            const f32x4 y4 = (*(const LAS f32x4*)(Ly + pt * 256 + pi) + *(const LAS f32x4*)(Ly + pt * 256 + 64 + pi)) + (*(const LAS f32x4*)(Ly + pt * 256 + 128 + pi) + *(const LAS f32x4*)(Ly + pt * 256 + 192 + pi)), v4 = *(const LAS f32x4*)(Lv + o); const float bon = Lbon[pt];
            const float mean = red16((y4[0] + y4[1]) + (y4[2] + y4[3])) * (1.0f / 64.0f);
            const f32x4 d = y4 - mean;
            const float var = red16((d[0] * d[0] + d[1] * d[1]) + (d[2] * d[2] + d[3] * d[3])) * (1.0f / 64.0f);
            const float rs = rsqrtf(var + 64e-5f);
            float z[4];
#pragma unroll
            for (int j = 0; j < 4; ++j) z[j] = (d[j] * rs * c_lg[j] + c_lb[j] + bon * v4[j]) * g_cur[j];
            u32x2 w; w.x = pk_bf16(z[0], z[1]); w.y = pk_bf16(z[2], z[3]);
            *(u32x2*)(Z + (row0 + (size_t)c * CH + pt) * 1024 + ch) = w;
        }
        if (c + 1 < NCH) WK_LORA();
    }
#undef WK_LOAD
#undef WK_LORA
}

#define XB_TMO      128
#define XB_XCNT(j)  (256  + 64 * (j))
#define XB_XSUB(j)  (1280 + 64 * (j))
#define XB_XGEN(j)  (2304 + 64 * (j))
#define XB_TOP      3328
#define XB_TOPGEN   3392
#define XCD_BAR_WORDS 3456
#define XB_SPIN_CAP (1u << 18)

__device__ __forceinline__ unsigned xb_ld(unsigned* p)              { return __hip_atomic_load(p, __ATOMIC_RELAXED, __HIP_MEMORY_SCOPE_AGENT); }
__device__ __forceinline__ unsigned xb_add(unsigned* p, unsigned v) { return __hip_atomic_fetch_add(p, v, __ATOMIC_RELAXED, __HIP_MEMORY_SCOPE_AGENT); }
__device__ __forceinline__ unsigned xb_xcc_id() { return (unsigned)__builtin_amdgcn_s_getreg((3 << 11) | 20) & 0xFu; }
#define XB_SPIN(cond, bar) do { unsigned _sp = 0; while (cond) { __builtin_amdgcn_s_sleep(1); \
    if ((++_sp & 255u) == 0u) { if (xb_ld(&(bar)[XB_TMO])) break; if (_sp > XB_SPIN_CAP) { atomicAdd(&(bar)[XB_TMO], 1u); break; } } } } while (0)

struct XcdBarrier {
    unsigned* bar; unsigned x;
    volatile LAS unsigned* st;
};

__device__ __forceinline__ XcdBarrier xcd_barrier_post(unsigned* bar, volatile LAS unsigned* st) {
    XcdBarrier b; b.bar = bar; b.x = xb_xcc_id(); b.st = st;
    if (threadIdx.x == 0) (void)xb_add(&bar[XB_XCNT(b.x)], 1u);
    return b;
}
__device__ __forceinline__ void xcd_barrier_complete(unsigned* bar, unsigned x, unsigned& nloc, unsigned& nx) {
    const unsigned G = gridDim.x * gridDim.y * gridDim.z;
    unsigned sum, cnt, mine, sp = 0u;
    for (;;) {
        sum = 0u; cnt = 0u; mine = 0u;
#pragma unroll
        for (unsigned j = 0; j < 16; ++j) { const unsigned c = xb_ld(&bar[XB_XCNT(j)]); sum += c; cnt += (c > 0u) ? 1u : 0u; mine = (j == x) ? c : mine; }
        if (sum == G) break;
        __builtin_amdgcn_s_sleep(1);
        if ((++sp & 255u) == 0u) { if (xb_ld(&bar[XB_TMO])) break; if (sp > XB_SPIN_CAP) { atomicAdd(&bar[XB_TMO], 1u); break; } }
    }
    nloc = mine > 0u ? mine : 1u; nx = cnt > 0u ? cnt : 1u;
}

__device__ __forceinline__ void xcd_barrier(const XcdBarrier& b) {
    asm volatile("s_waitcnt vmcnt(0)" ::: "memory");
    __syncthreads();
    if (threadIdx.x == 0) {
        unsigned* bar = b.bar;
        __builtin_amdgcn_s_waitcnt(0);
        unsigned nloc = b.st[0], nx = b.st[1];
        if (nloc == 0u) { xcd_barrier_complete(bar, b.x, nloc, nx); b.st[0] = nloc; b.st[1] = nx; }
        const unsigned old = xb_add(&bar[XB_XSUB(b.x)], 1u);
        const unsigned gen = old / nloc;
        if (old + 1u == (gen + 1u) * nloc) {
            __builtin_amdgcn_fence(__ATOMIC_RELEASE, "agent");
            asm volatile("s_waitcnt vmcnt(0)" ::: "memory");
            const unsigned og = xb_add(&bar[XB_TOP], 1u);
            const unsigned tg = og / nx;
            if (og + 1u == (tg + 1u) * nx) xb_add(&bar[XB_TOPGEN], 1u);
            else XB_SPIN(xb_ld(&bar[XB_TOPGEN]) == tg, bar);
            __builtin_amdgcn_fence(__ATOMIC_ACQUIRE, "agent");
            xb_add(&bar[XB_XGEN(b.x)], 1u);
            asm volatile("s_waitcnt vmcnt(0)" ::: "memory");
        } else {
            XB_SPIN(xb_ld(&bar[XB_XGEN(b.x)]) == gen, bar);
            __builtin_amdgcn_fence(__ATOMIC_ACQUIRE, "agent");
            asm volatile("s_waitcnt vmcnt(0)" ::: "memory");
        }
    }
    __syncthreads();
}

struct RstdOrder : pg8::StaticOrder {
    const float* SS; LAS float* rs; mutable int k;
    DI void a_ready(const pg8::Unit& u) const {
        const int tid = threadIdx.x;
        if (tid < 256) { const float* p = SS + (size_t)(u.pm * 256 + tid) * 16;
            const f32x4 q0 = *(const f32x4*)p, q1 = *(const f32x4*)(p + 4), q2 = *(const f32x4*)(p + 8), q3 = *(const f32x4*)(p + 12); const f32x4 qs = (q0 + q1) + (q2 + q3);
            rs[(k & 1) * 256 + tid] = rsqrtf(((qs[0] + qs[1]) + (qs[2] + qs[3])) * (1.0f / 1024.0f) + 1e-6f); }
        ++k;
    }
};
DI void run_gemm_up(LAS unsigned char* lds, const pg8::bf16_t* Amat, const pg8::bf16_t* Bt, const float* SS, u16* HID) {
    pg8::Gemm g{Amat, Bt, TT, 4096, 1024, 1024, 0}; RstdOrder S; S.init(TT, 4096, (int)gridDim.x, (int)blockIdx.x); S.SS = SS; S.rs = (LAS float*)(lds + 131072); S.k = 0;
    Epi<2> E{EpiArgs{HID, nullptr, nullptr, nullptr, nullptr, nullptr}}; E.rs = (const LAS float*)(lds + 131072); E.ucnt = 0;
    pg8::gemm_phase<Epi<2>, RstdOrder, true, true>(lds, g, S, E);
}
template <int MODE> DI void run_gemm(LAS unsigned char* lds, const pg8::bf16_t* Amat, const pg8::bf16_t* Bt, int N, int K, int lda, int amode, const EpiArgs& ea, int rev = 0) {
    pg8::Gemm g{Amat, Bt, TT, N, K, lda, amode}; pg8::StaticOrder S; S.init(TT, N, (int)gridDim.x, (int)blockIdx.x); S.rev = rev;
    Epi<MODE> E{ea}; E.rs = (const LAS float*)(lds + 133120);
    pg8::gemm_phase<Epi<MODE>, pg8::StaticOrder, true, true>(lds, g, S, E);
}

__global__ void __launch_bounds__(512, 2) mega_fwd(Args A) {
    extern __shared__ __attribute__((aligned(16))) unsigned char lds_raw[];
    LAS unsigned char* lds = (LAS unsigned char*)lds_raw;
    cg::grid_group grid = cg::this_grid();
    unsigned char* ws = A.ws;
    volatile LAS unsigned* bst = (volatile LAS unsigned*)(lds + LDS_TOTAL - 64);
    if (threadIdx.x < 2) bst[threadIdx.x] = 0u;
    __syncthreads();
    const XcdBarrier xbar = xcd_barrier_post((unsigned*)(ws + WS_BAR), bst);
#define GSYNC() xcd_barrier(xbar)
#define TIDS int tid = threadIdx.x; asm volatile("" : "+v"(tid) :: "memory"); const int lane = tid & 63, wave = __builtin_amdgcn_readfirstlane(tid >> 6); (void)lane; (void)wave;
    typedef pg8::bf16_t bt;
    { TIDS p0_prologue(A, lds, tid, lane, wave); }
    GSYNC();
    if (A.ws == nullptr) grid.sync();
    { TIDS if (blockIdx.x < 128) fox_cumsum(A, lds, (int)blockIdx.x, tid, lane, wave); }
    { EpiArgs ea{(u16*)(ws + WS_PROJ), nullptr, (const float*)(ws + WS_LB), A.in[8], nullptr, (float*)(ws + WS_SSK)};
      run_gemm<0>(lds, (const bt*)(ws + WS_XN), (const bt*)(ws + WS_WIN), 4096, 1024, 1024, 0, ea, 1); }
    GSYNC();
    {
        const attn_body::bf16* PB = (const attn_body::bf16*)(ws + WS_PROJ);
        const attn_body::AttnTensors AT{PB + 4 * PSTR, PB + 5 * PSTR, PB + 6 * PSTR, (attn_body::bf16*)(ws + WS_XN) + 512, (const float*)(ws + WS_SSK), (const float*)(ws + WS_CB), A.in[7], A.in[8], (const _Float16*)(ws + WS_PROJ) + 7 * PSTR};
        const attn_body::StaticOrder S((int)gridDim.x, (int)blockIdx.x);
        if (blockIdx.x < 128) { TIDS hgrn_mfma_phase(A, lds, tid, lane, wave); }
        __syncthreads();
        attn_body::attn_phase<attn_body::StaticOrder>((char*)lds_raw, AT, S);
    }
    GSYNC();
    { EpiArgs ea{(u16*)(ws + WS_HB), nullptr, A.in[0], nullptr, nullptr, (float*)(ws + WS_SS)};
      run_gemm<1>(lds, (const bt*)(ws + WS_XN), (const bt*)(ws + WS_WOUT), 1024, 1024, 1024, 0, ea); }
    GSYNC();
    run_gemm_up(lds, (const bt*)(ws + WS_HB), (const bt*)(ws + WS_WUP0), (const float*)(ws + WS_SS), (u16*)(ws + WS_PROJ));
    GSYNC();
    { EpiArgs ea{(u16*)A.out, (u16*)(ws + WS_HB), nullptr, nullptr, nullptr, nullptr};
      run_gemm<1>(lds, (const bt*)(ws + WS_PROJ), (const bt*)(ws + WS_WD0), 1024, 4096, 4096, 0, ea, 1); }
    GSYNC();
    { TIDS norm1_phase(A, lane, wave); }
    GSYNC();
    { EpiArgs ea{(u16*)(ws + WS_RKV), (u16*)(ws + WS_LH), nullptr, nullptr, nullptr, nullptr};
      run_gemm<3>(lds, (const bt*)(ws + WS_PROJ), (const bt*)(ws + WS_WBIG), 3072, 1024, 1024, 3, ea);
      run_gemm<5>(lds, (const bt*)(ws + WS_XN), (const bt*)(ws + WS_WLORA), 256, 2048, 1024, 1, ea); }
    GSYNC();
    { TIDS wkv_phase(A, lds, tid, lane, wave); }
    GSYNC();
    { EpiArgs ea{(u16*)(ws + WS_HB), (u16*)A.out, nullptr, nullptr, nullptr, (float*)(ws + WS_SS)};
      run_gemm<1>(lds, (const bt*)(ws + WS_XN), (const bt*)(ws + WS_WO), 1024, 1024, 1024, 0, ea); }
    GSYNC();
    run_gemm_up(lds, (const bt*)(ws + WS_HB), (const bt*)(ws + WS_WUP1), (const float*)(ws + WS_SS), (u16*)(ws + WS_PROJ));
    GSYNC();
    { EpiArgs ea{nullptr, (u16*)(ws + WS_HB), nullptr, nullptr, A.out, nullptr};
      run_gemm<1>(lds, (const bt*)(ws + WS_PROJ), (const bt*)(ws + WS_WD1), 1024, 4096, 4096, 0, ea, 1); }
}

extern "C" void kernel_launch(void* const* d_in, const int* in_sizes, int n_in, void* d_out, int out_size, void* d_ws, size_t ws_size, hipStream_t stream) {
    static int ready = 0;
    if (!ready) {
        if (n_in != 28 || ws_size < WS_END) { fprintf(stderr, "kernel_launch: unexpected n_in %d / ws_size %zu\n", n_in, ws_size); ready = -1; return; }
        if (hipFuncSetAttribute((const void*)mega_fwd, hipFuncAttributeMaxDynamicSharedMemorySize, LDS_TOTAL) != hipSuccess) { fprintf(stderr, "kernel_launch: hipFuncSetAttribute failed\n"); ready = -1; return; }
        int per_cu = 0; (void)hipOccupancyMaxActiveBlocksPerMultiprocessor(&per_cu, (const void*)mega_fwd, 512, LDS_TOTAL); (void)hipGetLastError();
        if (per_cu < 1) fprintf(stderr, "kernel_launch: occupancy query says %d blocks/CU\n", per_cu);
        ready = 1;
    }
    if (ready < 0) return;
    if (hipMemsetAsync((char*)d_ws + WS_BAR, 0, BAR_BYTES, stream) != hipSuccess) { fprintf(stderr, "kernel_launch: memset failed\n"); return; }
    Args a{};
    for (int i = 0; i < 28; ++i) a.in[i] = (const float*)d_in[i];
    a.out = (float*)d_out; a.ws = (unsigned char*)d_ws;
    void* args[] = {&a};
    hipError_t e = hipLaunchCooperativeKernel((const void*)mega_fwd, dim3(256), dim3(512), args, LDS_TOTAL, stream);
    if (e != hipSuccess) fprintf(stderr, "cooperative launch failed: %s\n", hipGetErrorString(e));
}
```

```cpp
#include <hip/hip_runtime.h>
#include <hip/hip_cooperative_groups.h>
#include <hip/hip_bf16.h>
#include <cstdio>
#include <cstdint>
#include <cmath>
namespace cg = cooperative_groups;

namespace pg8 {
#define PG8_LAS __attribute__((address_space(3)))
typedef unsigned short bf16_t;
typedef short bf16x8 __attribute__((ext_vector_type(8)));
typedef float f32x4 __attribute__((ext_vector_type(4)));
typedef unsigned u32x4 __attribute__((ext_vector_type(4)));
constexpr int BM = 256, BK = 64, HALF = 128, HTB = HALF * BK * 2  , STAGE_BYTES = 8 * HTB, NXCD = 8, WGM = 8;

__host__ __device__ __forceinline__ int lds_byte(int r, int c) { const int st = (r >> 4) * 2 + (c >> 5), rr = r & 15, cc = c & 31, ob = rr * 64 + cc * 2; return st * 1024 + (ob ^ (((ob >> 9) & 1) << 5)); }
__host__ __device__ __forceinline__ void stage_rc(int b, int& R, int& C) { const int st = b / 1024, sb = b % 1024, swz = sb ^ (((sb >> 9) & 1) << 5); R = (st >> 1) * 16 + swz / 64; C = (st & 1) * 32 + (swz % 64) / 2; }
__host__ __device__ __forceinline__ int perm32(int rho) { const int n = rho >> 4, i = rho & 15; return 8 * (i >> 2) + 4 * n + (i & 3); }

struct Unit { int pm, pn; };
struct Gemm { const bf16_t* A; const bf16_t* Bt; int M, N, K, lda, amode; };
__device__ __forceinline__ const char* a_base(const Gemm& g, const Unit& u) {
    if (g.amode == 1) return (const char*)g.A + (size_t)((u.pm >> 4) * 4097 + 1 + (u.pm & 15) * 256) * g.lda * 2;
    if (g.amode == 3) return (const char*)g.A + (size_t)(u.pn >> 2) * ((size_t)65536 * 1024 * 2) + (size_t)u.pm * 256 * g.lda * 2;
    if (g.amode == 2) return (const char*)g.A + (size_t)u.pm * 256 * g.lda * 2 + (size_t)(u.pn >> 2) * 128;
    return (const char*)g.A + (size_t)u.pm * 256 * g.lda * 2;
}
struct StaticOrder {
    int nM, nN, nwg, G, c, rev = 0;
    __host__ __device__ void init(int M, int N, int G_, int c_) { nM = M / BM; nN = N / BM; nwg = nM * nN; G = G_; c = c_; }
    __host__ __device__ bool next(int i, Unit& u) const {
        const long L = (long)i * G + c; if (L >= nwg) return false;
        int wgid = (int)L; { const int q = nwg / NXCD, r = nwg % NXCD, xcd = wgid % NXCD, off = wgid / NXCD; wgid = (xcd < r ? xcd * (q + 1) : r * (q + 1) + (xcd - r) * q) + off; }
        const int nig = WGM * nN, gid = wgid / nig, fm = gid * WGM, gsz = (nM - fm) < WGM ? (nM - fm) : WGM;
        u.pm = fm + ((wgid % nig) % gsz); u.pn = (wgid % nig) / gsz; if (rev) u.pm = nM - 1 - u.pm; return true;
    }
    __device__ __forceinline__ void a_ready(const Unit&) const {}
    __device__ __forceinline__ void done(const Unit&) const {}
};
template <class Epi, class Sched, bool ALIGN_EPI = false, bool SP2 = false>
__device__ __forceinline__ void gemm_phase(PG8_LAS unsigned char* lds, const Gemm g, const Sched& S, const Epi& E) {
    int tid = threadIdx.x; asm volatile("" : "+v"(tid) :: "memory"); const int wid = __builtin_amdgcn_readfirstlane(tid >> 6), lane = tid & 63, wr = wid >> 2, wc = wid & 3, fr = lane & 15, fq = lane >> 4;
    const int K = g.K, nt = K / BK;
    unsigned voffA[2], voffB[2];
#pragma unroll
    for (int i = 0; i < 2; ++i) { int R, C; stage_rc(tid * 16 + i * 8192, R, C); const int Rb = Epi::PERM ? ((R & ~31) + perm32(R & 31)) : R;
        voffA[i] = (unsigned)(R * g.lda + C) * 2u; voffB[i] = (unsigned)(Rb * K + C) * 2u; }
    const size_t kstep = (size_t)(BK * 2);
    const size_t hstepB = (size_t)HALF * K * 2, hstepA = (size_t)HALF * g.lda * 2;
    const size_t tstepB = 2 * hstepB; const int shT = (g.amode == 1) ? 16 : (1 << 30); const size_t shB = (size_t)(g.lda + 1024) * 2;
    const unsigned ldsw = (unsigned)wid * 1024u;
    const int aoff = lds_byte(wr * 64 + fr, fq * 8), boff = lds_byte(wc * 32 + fr, fq * 8);
#define PG8_SA(b, h) (((b) * 2 + (h)) * HTB)
#define PG8_SB(b, h) ((4 + (b) * 2 + (h)) * HTB)
#define PG8_STAGE(bufoff, gbase, voff) do { _Pragma("unroll") for (int _i = 0; _i < 2; ++_i) \
        __builtin_amdgcn_global_load_lds((const unsigned*)((const char*)(gbase) + (voff)[_i]), (PG8_LAS unsigned*)(lds + (bufoff) + ldsw + _i * 8192), 16, 0, 0); } while (0)
#define PG8_LDA(dst, b, h) do { _Pragma("unroll") for (int m = 0; m < 4; ++m) _Pragma("unroll") for (int k = 0; k < 2; ++k) dst[m][k] = *(const PG8_LAS bf16x8*)(lds + PG8_SA(b, h) + aoff + m * 2048 + k * 1024); } while (0)
#define PG8_LDB(dst, b, h) do { _Pragma("unroll") for (int n = 0; n < 2; ++n) _Pragma("unroll") for (int k = 0; k < 2; ++k) dst[n][k] = *(const PG8_LAS bf16x8*)(lds + PG8_SB(b, h) + boff + n * 2048 + k * 1024); } while (0)
#define PG8_MMA(ai, bj, At, Bt) do { __builtin_amdgcn_s_setprio(1); _Pragma("unroll") for (int m = 0; m < 4; ++m) _Pragma("unroll") for (int n = 0; n < 2; ++n) _Pragma("unroll") for (int k = 0; k < 2; ++k) \
        acc[ai][bj][m][n] = __builtin_amdgcn_mfma_f32_16x16x32_bf16(Bt[n][k], At[m][k], acc[ai][bj][m][n], 0, 0, 0); __builtin_amdgcn_s_setprio(0); } while (0)
#define PG8_WAIT_V(n) asm volatile("s_waitcnt vmcnt(" #n ")" ::: "memory")
#define PG8_WAIT_L(n) asm volatile("s_waitcnt lgkmcnt(" #n ")" ::: "memory")
#define PG8_BAR __builtin_amdgcn_s_barrier()
#define PG8_SCHED __builtin_amdgcn_sched_barrier(0)
    Unit cur, nxt; int ui = 0;
    if (!S.next(0, cur)) return;
    f32x4 acc[2][2][4][2];
#pragma unroll
    for (int a = 0; a < 2; ++a)
#pragma unroll
        for (int b = 0; b < 2; ++b)
#pragma unroll
            for (int m = 0; m < 4; ++m)
#pragma unroll
                for (int n = 0; n < 2; ++n) acc[a][b][m][n] = (f32x4){0.f, 0.f, 0.f, 0.f};
    bf16x8 At[4][2], B0[2][2], B1[2][2];
    const char* cA = a_base(g, cur); const char* cB = (const char*)g.Bt + (size_t)cur.pn * tstepB;
    S.a_ready(cur);
    if constexpr (SP2) {
        PG8_STAGE(PG8_SB(0, 0), cB, voffB); PG8_STAGE(PG8_SB(0, 1), cB + hstepB, voffB); PG8_STAGE(PG8_SA(0, 0), cA, voffA); PG8_STAGE(PG8_SA(0, 1), cA + hstepA, voffA);
        if (wr == 1) PG8_BAR;
        PG8_WAIT_V(2); PG8_BAR;
        PG8_STAGE(PG8_SB(1, 0), cB + kstep, voffB); PG8_STAGE(PG8_SA(1, 0), cA + kstep, voffA); PG8_STAGE(PG8_SB(1, 1), cB + hstepB + kstep, voffB);
        PG8_WAIT_V(6); PG8_BAR;
    } else {
        PG8_STAGE(PG8_SB(0, 0), cB, voffB); PG8_STAGE(PG8_SA(0, 0), cA, voffA); PG8_STAGE(PG8_SB(0, 1), cB + hstepB, voffB); PG8_STAGE(PG8_SA(0, 1), cA + hstepA, voffA);
        if (wr == 1) PG8_BAR;
        PG8_WAIT_V(4); PG8_BAR;
        PG8_STAGE(PG8_SB(1, 0), cB + kstep, voffB); PG8_STAGE(PG8_SA(1, 0), cA + kstep, voffA); PG8_STAGE(PG8_SB(1, 1), cB + hstepB + kstep, voffB);
        PG8_WAIT_V(6); PG8_BAR;
    }
    for (;;) {
        const bool has_next = S.next(ui + 1, nxt);
        const char* nA = has_next ? a_base(g, nxt) : cA; const char* nB = has_next ? (const char*)g.Bt + (size_t)nxt.pn * tstepB : cB;
        for (int t = 0; t < nt; t += 2) {
            const bool last = (t == nt - 2);
            const char* a1 = cA + (size_t)(t + 1) * kstep - ((t + 1) >= shT ? shB : 0);
            const char* a2 = last ? nA : cA + (size_t)(t + 2) * kstep - ((t + 2) >= shT ? shB : 0); const char* b2 = last ? nB : cB + (size_t)(t + 2) * kstep;
            const char* a3 = last ? nA + kstep : cA + (size_t)(t + 3) * kstep - ((t + 3) >= shT ? shB : 0); const char* b3 = b2 + kstep;
            if (last && has_next) S.a_ready(nxt);
            if constexpr (SP2) {
            PG8_LDB(B0, 0, 0); PG8_LDB(B1, 0, 1); PG8_SCHED; PG8_LDA(At, 0, 0); PG8_STAGE(PG8_SA(1, 1), a1 + hstepA, voffA);
            PG8_WAIT_V(8); PG8_WAIT_L(0); PG8_BAR; PG8_MMA(0, 0, At, B0); PG8_MMA(0, 1, At, B1); PG8_BAR; PG8_SCHED;
            PG8_LDA(At, 0, 1); PG8_STAGE(PG8_SB(0, 0), b2, voffB); PG8_STAGE(PG8_SB(0, 1), b2 + hstepB, voffB); PG8_STAGE(PG8_SA(0, 0), a2, voffA);
            PG8_WAIT_V(8); PG8_WAIT_L(0); PG8_BAR; PG8_MMA(1, 0, At, B0); PG8_MMA(1, 1, At, B1); PG8_BAR; PG8_SCHED;
            PG8_LDB(B0, 1, 0); PG8_LDB(B1, 1, 1); PG8_SCHED; PG8_LDA(At, 1, 0); PG8_STAGE(PG8_SA(0, 1), a2 + hstepA, voffA);
            PG8_WAIT_V(8); PG8_WAIT_L(0); PG8_BAR; PG8_MMA(0, 0, At, B0); PG8_MMA(0, 1, At, B1); PG8_BAR; PG8_SCHED;
            PG8_LDA(At, 1, 1); PG8_STAGE(PG8_SB(1, 0), b3, voffB); PG8_STAGE(PG8_SB(1, 1), b3 + hstepB, voffB); PG8_STAGE(PG8_SA(1, 0), a3, voffA);
            PG8_WAIT_V(8); PG8_WAIT_L(0); PG8_BAR; PG8_MMA(1, 0, At, B0); PG8_MMA(1, 1, At, B1); PG8_BAR; PG8_SCHED;
            } else {
            PG8_LDB(B0, 0, 0); PG8_SCHED; PG8_LDA(At, 0, 0); PG8_STAGE(PG8_SA(1, 1), a1 + hstepA, voffA);
            PG8_WAIT_L(8); PG8_BAR; PG8_WAIT_L(0); PG8_MMA(0, 0, At, B0); PG8_BAR; PG8_SCHED;
            PG8_LDB(B1, 0, 1); PG8_STAGE(PG8_SB(0, 0), b2, voffB);
            PG8_BAR; PG8_WAIT_L(0); PG8_MMA(0, 1, At, B1); PG8_BAR;
            PG8_LDA(At, 0, 1); PG8_STAGE(PG8_SA(0, 0), a2, voffA);
            PG8_BAR; PG8_WAIT_L(0); PG8_MMA(1, 0, At, B0); PG8_BAR; PG8_SCHED;
            PG8_STAGE(PG8_SB(0, 1), b2 + hstepB, voffB);
            PG8_WAIT_V(6); PG8_BAR; PG8_MMA(1, 1, At, B1); PG8_BAR;
            PG8_LDB(B0, 1, 0); PG8_SCHED; PG8_LDA(At, 1, 0); PG8_STAGE(PG8_SA(0, 1), a2 + hstepA, voffA);
            PG8_WAIT_L(8); PG8_BAR; PG8_WAIT_L(0); PG8_MMA(0, 0, At, B0); PG8_BAR; PG8_SCHED;
            PG8_LDB(B1, 1, 1); PG8_STAGE(PG8_SB(1, 0), b3, voffB);
            PG8_BAR; PG8_WAIT_L(0); PG8_MMA(0, 1, At, B1); PG8_BAR;
            PG8_LDA(At, 1, 1); PG8_STAGE(PG8_SA(1, 0), a3, voffA);
            PG8_BAR; PG8_WAIT_L(0); PG8_MMA(1, 0, At, B0); PG8_BAR; PG8_SCHED;
            PG8_STAGE(PG8_SB(1, 1), b3 + hstepB, voffB);
            PG8_WAIT_V(6); PG8_BAR; PG8_MMA(1, 1, At, B1); PG8_BAR;
            }
        }
        if constexpr (ALIGN_EPI) { if (wr == 0) PG8_BAR; }
        if constexpr (!Epi::AFTER_DRAIN) { E(acc, cur, wr, wc, fr, fq); S.done(cur); }
        if (!has_next) break;
#pragma unroll
        for (int a = 0; a < 2; ++a)
#pragma unroll
            for (int b = 0; b < 2; ++b)
#pragma unroll
                for (int m = 0; m < 4; ++m)
#pragma unroll
                    for (int n = 0; n < 2; ++n) acc[a][b][m][n] = (f32x4){0.f, 0.f, 0.f, 0.f};
        cur = nxt; cA = nA; cB = nB; ++ui;
        if constexpr (ALIGN_EPI) { if (wr == 1) PG8_BAR; }
    }
    PG8_WAIT_V(0);
    if constexpr (!ALIGN_EPI) { if (wr == 0) PG8_BAR; }
    PG8_BAR;
    if constexpr (Epi::AFTER_DRAIN) { E.fused(acc, cur, wr, wc, fr, fq, lds, wid, lane); S.done(cur); }
#undef PG8_SA
#undef PG8_SB
#undef PG8_STAGE
#undef PG8_LDA
#undef PG8_LDB
#undef PG8_MMA
#undef PG8_WAIT_V
#undef PG8_WAIT_L
#undef PG8_BAR
#undef PG8_SCHED
}
}
#include <hip/hip_bf16.h>
#include <cmath>
namespace attn_body {
using bf16=__hip_bfloat16;
using bf16x8=__attribute__((ext_vector_type(8)))short;
using s16x4=__attribute__((ext_vector_type(4)))short;
using f32x16=__attribute__((ext_vector_type(16)))float;
using u32x4=__attribute__((ext_vector_type(4)))unsigned;
constexpr int BATCH=16,NHEAD=8,SEQ=4096,D=64,DM=512,OPITCH=1024;
constexpr int NW=8,QBLK=32,QB=QBLK*NW,KVBLK=64,NQB=SEQ/QB;
constexpr int ATTN_PITCH=DM, ATTN_UNIT_ROWS=QB;
__device__ __forceinline__ int crow(int r,int hi){return (r&3)+8*(r>>2)+4*hi;}
#define SBAR() __builtin_amdgcn_sched_barrier(0)
__device__ __forceinline__ void cmask(f32x16&p0,f32x16&p1,int jb,int qrel,int hi){
  const float NEG=-INFINITY; int kb=64*jb+4*hi;
  #pragma unroll
  for(int r=0;r<16;++r){int kv=kb+(r&3)+8*(r>>2); if(kv>qrel)p0[r]=NEG; if(kv+32>qrel)p1[r]=NEG;}
}

constexpr int NSLOT=3, SLOTB=8192;
constexpr int LDS_K=0, LDS_V=NSLOT*SLOTB, LDS_WS=2*NSLOT*SLOTB, LDS_OST=LDS_WS+NW*64*4, LDS_CB=LDS_OST+NW*4096, LDS_BYTES=LDS_CB+SEQ*4;
constexpr float C2=0.125f*1.4426950408889634f;
__device__ __forceinline__ void glds16(const void*gsrc,unsigned lds_dst){unsigned keep;
  asm volatile("s_mov_b32 %0, m0\n\ts_mov_b32 m0, %2\n\ts_nop 0\n\tglobal_load_lds_dwordx4 %1, off\n\ts_mov_b32 m0, %0":"=&s"(keep):"v"(gsrc),"s"(lds_dst):"memory");}
__device__ __forceinline__ float max3f(float a,float b,float c){float r;asm("v_max3_f32 %0, %1, %2, %3":"=v"(r):"v"(a),"v"(b),"v"(c));return r;}
__device__ __forceinline__ float max2f(float a,float b){float r;asm("v_max_f32_e32 %0, %1, %2":"=v"(r):"v"(a),"v"(b));return r;}
__device__ __forceinline__ float fadd_s(float a,float b){float r;asm("v_add_f32_e32 %0, %1, %2":"=v"(r):"v"(a),"v"(b));return r;}
__device__ __forceinline__ float fsub_s(float a,float b){float r;asm("v_sub_f32_e32 %0, %1, %2":"=v"(r):"v"(a),"v"(b));return r;}
typedef float f32x2_t __attribute__((ext_vector_type(2))); typedef __bf16 bf16x2_t __attribute__((ext_vector_type(2)));
__device__ __forceinline__ unsigned cvtpk_s(float lo,float hi){f32x2_t v={lo,hi};bf16x2_t b=__builtin_convertvector(v,bf16x2_t);return __builtin_bit_cast(unsigned,b);}
#define WAIT_BAR(N) asm volatile("s_waitcnt vmcnt(" #N ") lgkmcnt(0)\n\ts_barrier":::"memory")

__device__ __forceinline__ void qkt(f32x16&p0,f32x16&p1,const char*Kslot,const bf16x8*qr,const f32x16&negm,int r32,int hi){
  const char*kb=Kslot+hi*1024+r32*16;
  #pragma unroll
  for(int d0=0;d0<4;++d0){
    const bf16x8 b0=*reinterpret_cast<const bf16x8*>(kb+d0*2048);
    const bf16x8 b1=*reinterpret_cast<const bf16x8*>(kb+d0*2048+512);
    p0=__builtin_amdgcn_mfma_f32_32x32x16_bf16(b0,qr[d0],p0,0,0,0);p1=__builtin_amdgcn_mfma_f32_32x32x16_bf16(b1,qr[d0],p1,0,0,0);}
}
typedef __attribute__((address_space(3))) const char* lds_cptr;
typedef short v4i16_t __attribute__((ext_vector_type(4)));
__device__ __forceinline__ void kload8(bf16x8*kf,lds_cptr kp){
  kf[0]=*(const __attribute__((address_space(3))) bf16x8*)(kp);      kf[1]=*(const __attribute__((address_space(3))) bf16x8*)(kp+512);
  kf[2]=*(const __attribute__((address_space(3))) bf16x8*)(kp+2048); kf[3]=*(const __attribute__((address_space(3))) bf16x8*)(kp+2560);
  kf[4]=*(const __attribute__((address_space(3))) bf16x8*)(kp+4096); kf[5]=*(const __attribute__((address_space(3))) bf16x8*)(kp+4608);
  kf[6]=*(const __attribute__((address_space(3))) bf16x8*)(kp+6144); kf[7]=*(const __attribute__((address_space(3))) bf16x8*)(kp+6656);
}
__device__ __forceinline__ void kload2(bf16x8*kf,lds_cptr kp,int j){ kf[2*j]=*(const __attribute__((address_space(3))) bf16x8*)(kp+j*2048); kf[2*j+1]=*(const __attribute__((address_space(3))) bf16x8*)(kp+j*2048+512); }
__device__ __forceinline__ s16x4 vtr(lds_cptr p){ return __builtin_bit_cast(s16x4,__builtin_amdgcn_ds_read_tr16_b64_v4i16((__attribute__((address_space(3))) v4i16_t*)p)); }
__device__ __forceinline__ float rowmax(const f32x16&p0,const f32x16&p1){
  float a=max3f(p0[0],p0[1],p1[0]),b=max3f(p0[2],p0[3],p1[1]);a=max3f(a,p1[2],p1[3]);
  #pragma unroll
  for(int r=4;r<16;r+=4){a=max3f(a,p0[r],p0[r+1]);b=max3f(b,p0[r+2],p0[r+3]);a=max3f(a,p1[r],p1[r+1]);b=max3f(b,p1[r+2],p1[r+3]);}
  const float m=max2f(a,b);
  auto rr=__builtin_amdgcn_permlane32_swap(__float_as_uint(m),__float_as_uint(m),false,false);
  return max2f(__uint_as_float(rr[0]),__uint_as_float(rr[1]));
}
__device__ __forceinline__ void pv(f32x16*o,int vb,bf16x8 pa0,bf16x8 pa1,bf16x8 pa2,bf16x8 pa3){
  #pragma unroll
  for(int d0=0;d0<2;++d0){s16x4 lo[4],hi[4];
    #pragma unroll
    for(int ks=0;ks<4;++ks){
      asm volatile("ds_read_b64_tr_b16 %0,%1 offset:%c2":"=&v"(lo[ks]):"v"(vb),"i"(d0*4096+ks*1024):"memory");
      asm volatile("ds_read_b64_tr_b16 %0,%1 offset:%c2":"=&v"(hi[ks]):"v"(vb),"i"(d0*4096+ks*1024+512):"memory");}
    asm volatile("s_waitcnt lgkmcnt(0)":::"memory");SBAR();
    #define PK(k) (bf16x8){lo[k][0],lo[k][1],lo[k][2],lo[k][3],hi[k][0],hi[k][1],hi[k][2],hi[k][3]}
    o[d0]=__builtin_amdgcn_mfma_f32_32x32x16_bf16(pa0,PK(0),o[d0],0,0,0);
    o[d0]=__builtin_amdgcn_mfma_f32_32x32x16_bf16(pa1,PK(1),o[d0],0,0,0);
    o[d0]=__builtin_amdgcn_mfma_f32_32x32x16_bf16(pa2,PK(2),o[d0],0,0,0);
    o[d0]=__builtin_amdgcn_mfma_f32_32x32x16_bf16(pa3,PK(3),o[d0],0,0,0);
    #undef PK
  }
}


typedef __attribute__((address_space(3))) const float* lds_fptr;
typedef float f32x4a __attribute__((ext_vector_type(4)));
__device__ __forceinline__ void bias_scale(f32x16&p0,f32x16&p1,lds_fptr rk,lds_fptr cb,float mhat,int hi){
  #pragma unroll
  for(int j=0;j<4;++j){
    const f32x4a r0=*(const __attribute__((address_space(3))) f32x4a*)(rk+8*j+4*hi), c0=*(const __attribute__((address_space(3))) f32x4a*)(cb+8*j+4*hi);
    const f32x4a r1=*(const __attribute__((address_space(3))) f32x4a*)(rk+32+8*j+4*hi), c1=*(const __attribute__((address_space(3))) f32x4a*)(cb+32+8*j+4*hi);
    #pragma unroll
    for(int i=0;i<4;++i){ p0[4*j+i]=__builtin_fmaf(p0[4*j+i],r0[i],c0[i])-mhat; p1[4*j+i]=__builtin_fmaf(p1[4*j+i],r1[i],c1[i])-mhat; }
    SBAR();
  }
}
#ifndef ATTN_STORE16
#define ATTN_STORE16(p,v) (*(u32x4*)(p)=(v))
#endif
template<int THRL> __device__ __forceinline__ void attn_unit(int b,int h,int qb,const bf16*Q,const bf16*__restrict__ K,const bf16*__restrict__ V,bf16*O,const float*__restrict__ SSK,const float*__restrict__ CBG,const float*__restrict__ GQ,const float*__restrict__ GK,const _Float16*__restrict__ BG,char*shm){
  int tid=threadIdx.x; asm volatile("":"+v"(tid)::"memory"); const int lane=tid&63,r32=lane&31,hi=lane>>5; const int wid=__builtin_amdgcn_readfirstlane(tid>>6);
  const long rowbase=(long)b*SEQ; const int q0=qb*QB;
  const bf16*Qw=Q+(rowbase+q0+wid*QBLK)*DM+h*D;
  int ts=0;
  { const float*cbg=CBG+(size_t)(b*NHEAD+h)*SEQ; float gqm=fabsf(GQ[lane]),gkm=fabsf(GK[lane]);
    #pragma unroll
    for(int o_=1;o_<64;o_<<=1){ gqm=fmaxf(gqm,__shfl_xor(gqm,o_)); gkm=fmaxf(gkm,__shfl_xor(gkm,o_)); }
    const float B2=64.0f*C2*gqm*gkm*1.1f+1.0f, thr=cbg[q0]-2.0f*B2-46.0f; const int npre=q0/KVBLK;
    const float ve=(lane<npre)?cbg[64*lane+63]:3.0e38f;
    ts=__builtin_popcountll(__ballot(ve<thr))&~1; ts=__builtin_amdgcn_readfirstlane(ts); }
  const bf16*Kh=K+(rowbase+(long)ts*KVBLK)*DM+h*D,*Vh=V+(rowbase+(long)ts*KVBLK)*DM+h*D;
  const lds_cptr shm3=(lds_cptr)shm;
  const unsigned lds0=(unsigned)(uintptr_t)shm;
  float*wsf=(float*)(shm+LDS_WS)+wid*64;
  const bf16*ksrc=Kh+(long)lane*DM+wid*8;
  const bf16*vsrc=Vh+(long)(16*(wid&3)+(lane>>2))*DM+(wid>>2)*32+(lane&3)*8;
  const unsigned kdst=lds0+LDS_K+wid*1024, vdst=lds0+LDS_V+wid*1024;
  #define DMA_K(t,slot) glds16(ksrc+(long)(t)*KVBLK*DM,(unsigned)__builtin_amdgcn_readfirstlane(kdst+(slot)))
  #define DMA_V(t,slot) glds16(vsrc+(long)(t)*KVBLK*DM,(unsigned)__builtin_amdgcn_readfirstlane(vdst+(slot)))
  const int vb0=(int)(lds0+LDS_V)+((lane>>4)&1)*32+(lane&3)*8+(4*hi+((lane&15)>>2))*64;
  const char*Kbase=shm+LDS_K; bf16x8 kf[8];
  const lds_cptr kp0=shm3+LDS_K+hi*1024+r32*16; const lds_cptr vp0=shm3+LDS_V+((lane>>4)&1)*32+(lane&3)*8+(4*hi+((lane&15)>>2))*64;
  const int NT=(q0+QB)/KVBLK-ts;
  { float*cbl=(float*)(shm+LDS_CB); const int nk=q0+QB;
    for(int s=ts*KVBLK+tid;s<nk;s+=NW*64){ cbl[s-ts*KVBLK]=CBG[(size_t)(b*NHEAD+h)*SEQ+s]; } }
  const lds_fptr cb3=(lds_fptr)(shm3+LDS_CB);
  DMA_K(0,0);DMA_V(0,0);DMA_K(1,SLOTB);
  bf16x8 qr[4];
  #pragma unroll
  for(int d0=0;d0<4;++d0)qr[d0]=*reinterpret_cast<const bf16x8*>(&Qw[(long)r32*DM+d0*16+hi*8]);
  { float qss=0.f;
    #pragma unroll
    for(int d0=0;d0<4;++d0)
      #pragma unroll
      for(int j=0;j<8;++j){ const float qv=__uint_as_float(((unsigned)(unsigned short)qr[d0][j])<<16); qss+=qv*qv; }
    qss+=__shfl_xor(qss,32);
    const float qrs=rsqrtf(qss*(1.0f/64.0f)+1e-6f)*C2;
    #pragma unroll
    for(int d0=0;d0<4;++d0){ unsigned w_[4];
      #pragma unroll
      for(int j=0;j<8;j+=2){ const int dd=d0*16+hi*8+j;
        const float v0=__uint_as_float(((unsigned)(unsigned short)qr[d0][j])<<16)*qrs*GQ[dd];
        const float v1=__uint_as_float(((unsigned)(unsigned short)qr[d0][j+1])<<16)*qrs*GQ[dd+1];
        w_[j>>1]=cvtpk_s(v0,v1); }
      qr[d0]=__builtin_bit_cast(bf16x8,(u32x4){w_[0],w_[1],w_[2],w_[3]}); } }
  float mhat=0.f,l_reg=0.f;f32x16 o[2];o[0]=f32x16{};o[1]=f32x16{};const f32x16 negm=f32x16{};
  #define CINIT1(C0_,off_,t_,mh_) do{ const lds_fptr cbp_=cb3+64*(t_)+4*hi+(off_); \
    _Pragma("unroll") for(int j_=0;j_<4;++j_){ const f32x4a c0_=*(const __attribute__((address_space(3))) f32x4a*)(cbp_+8*j_); \
      _Pragma("unroll") for(int i_=0;i_<4;++i_){ C0_[4*j_+i_]=c0_[i_]-(mh_); } } }while(0)
  #define CINIT(C0_,C1_,t_,mh_) do{ CINIT1(C0_,0,t_,mh_); CINIT1(C1_,32,t_,mh_); }while(0)
  const int qrel=wid*QBLK+r32;
  #define CMASK(P0,P1,t) do{int jb_=(t)-(NT-4); if(jb_>=0)cmask(P0,P1,jb_,qrel,hi);}while(0)
  bool resc=false;
  #define START(P0,P1) do{ const float rm=rowmax(P0,P1); resc=false; \
    { const float dl=rm; mhat=fadd_s(mhat,dl); \
      _Pragma("unroll") for(int r=0;r<16;++r){P0[r]=fsub_s(P0[r],dl);P1[r]=fsub_s(P1[r],dl);} \
      } \
    _Pragma("unroll") for(int r=0;r<16;++r)P0[r]=__builtin_amdgcn_exp2f(P0[r]); }while(0)
  #define RESC() do{ if(resc){ asm volatile("s_waitcnt lgkmcnt(0)":::"memory"); \
      _Pragma("unroll") for(int d_=0;d_<2;++d_) _Pragma("unroll") for(int r=0;r<16;++r)o[d_][r]*=wsf[crow(r,hi)]; } }while(0)
  f32x16 pA0,pA1,pB0,pB1;
  int sl_prev=0,sl_cur=0,sl_next=SLOTB;
  #define ROT() do{sl_prev=sl_cur;sl_cur=sl_next;sl_next=(sl_next==(NSLOT-1)*SLOTB)?0:sl_next+SLOTB;}while(0)
  DMA_K(2,2*SLOTB);
  WAIT_BAR(3);
  CINIT(pA0,pA1,0,0.f);qkt(pA0,pA1,Kbase,qr,negm,r32,hi);asm volatile("s_nop 15\n\ts_nop 7":"+v"(pA0),"+v"(pA1));CMASK(pA0,pA1,0);
  START(pA0,pA1);
  _Pragma("unroll") for(int r=0;r<16;++r)pA1[r]=__builtin_amdgcn_exp2f(pA1[r]);
  WAIT_BAR(0);
  DMA_K(3,0);DMA_V(1,SLOTB);
  ROT();
  kload8(kf,kp0+sl_cur);
  WAIT_BAR(2);
  s16x4 vlo[8],vhi[8]; u32x4 pw0,pw1,pw2,pw3;
  #define PKW(P,B) cvtpk_s(P[B],P[B+1])
  #define PAF(k) __builtin_bit_cast(bf16x8,pw##k)
  #define VFR(i) (bf16x8){vlo[i][0],vlo[i][1],vlo[i][2],vlo[i][3],vhi[i][0],vhi[i][1],vhi[i][2],vhi[i][3]}
  #define PIN(x) asm volatile("":"+v"(x))
  #define MX3(a,b,c) __builtin_fmaxf(__builtin_fmaxf((a),(b)),(c))
  #define GAPA(MF,A0,A1,A2,A3,W0,W1,PW) do{ MF; sacc+=A0; sacc+=A1; sacc+=A2; sacc+=A3; PIN(sacc); W0; W1; PIN(PW); SBAR(); }while(0)
  #define EX(v) __builtin_amdgcn_exp2f(v)
  #define GAPB(MF,X,B) do{ MF; X[B]=EX(X[B]); X[B+1]=EX(X[B+1]); X[B+2]=EX(X[B+2]); X[B+3]=EX(X[B+3]); PIN(X); SBAR(); }while(0)
  #define VRD(i) do{ vlo[i]=vtr(vp_+(((i)>>2)*4096+((i)&3)*1024)); vhi[i]=vtr(vp_+(((i)>>2)*4096+((i)&3)*1024+512)); }while(0)
  #define KRD(G,j) do{ if(G){ kload2(kf,kp0+sl_next,j); SBAR(); } }while(0)
  #define STEP(C0,C1,P0,P1,t,GK,GV,GL) do{ SBAR(); \
    const lds_cptr vp_=vp0+sl_prev; CINIT1(C0,0,t,mhat); SBAR(); \
    VRD(0); SBAR(); float sacc=(P0[0]+P0[1]); \
    GAPA(C0=__builtin_amdgcn_mfma_f32_32x32x16_bf16(kf[0],qr[0],C0,0,0,0), P0[2],P0[3],P0[4],P0[5],     pw0[0]=PKW(P0,0), pw0[1]=PKW(P0,2), pw0); \
    CINIT1(C1,32,t,mhat); SBAR(); VRD(4); SBAR(); GAPA(C1=__builtin_amdgcn_mfma_f32_32x32x16_bf16(kf[1],qr[0],C1,0,0,0), P0[6],P0[7],P0[8],P0[9],     pw0[2]=PKW(P0,4), pw0[3]=PKW(P0,6), pw0); \
    VRD(1); SBAR(); GAPA(C0=__builtin_amdgcn_mfma_f32_32x32x16_bf16(kf[2],qr[1],C0,0,0,0),   P0[10],P0[11],P0[12],P0[13], pw1[0]=PKW(P0,8), pw1[1]=PKW(P0,10), pw1); \
    VRD(5); SBAR(); GAPA(C1=__builtin_amdgcn_mfma_f32_32x32x16_bf16(kf[3],qr[1],C1,0,0,0),   P0[14],P0[15],P1[0],P1[1],   pw1[2]=PKW(P0,12),pw1[3]=PKW(P0,14), pw1); \
    VRD(2); SBAR(); GAPA(C0=__builtin_amdgcn_mfma_f32_32x32x16_bf16(kf[4],qr[2],C0,0,0,0),   P1[2],P1[3],P1[4],P1[5],     pw2[0]=PKW(P1,0), pw2[1]=PKW(P1,2), pw2); \
    VRD(6); SBAR(); GAPA(C1=__builtin_amdgcn_mfma_f32_32x32x16_bf16(kf[5],qr[2],C1,0,0,0),   P1[6],P1[7],P1[8],P1[9],     pw2[2]=PKW(P1,4), pw2[3]=PKW(P1,6), pw2); \
    VRD(3); SBAR(); GAPA(C0=__builtin_amdgcn_mfma_f32_32x32x16_bf16(kf[6],qr[3],C0,0,0,0),   P1[10],P1[11],P1[12],P1[13], pw3[0]=PKW(P1,8), pw3[1]=PKW(P1,10), pw3); \
    VRD(7); SBAR(); GAPA(C1=__builtin_amdgcn_mfma_f32_32x32x16_bf16(kf[7],qr[3],C1,0,0,0),   P1[14],P1[15],0.f,0.f,       pw3[2]=PKW(P1,12),pw3[3]=PKW(P1,14), pw3); \
    l_reg+=sacc; \
    if(GK){DMA_K((t)+3,sl_cur);} if(GV){DMA_V((t)+1,sl_next);} \
    CMASK(C0,C1,t); \
    { float a=MX3(C0[0],C0[1],C1[0]),b=MX3(C0[2],C0[3],C1[1]); a=MX3(a,C1[2],C1[3]); \
      _Pragma("unroll") for(int r=4;r<16;r+=4){a=MX3(a,C0[r],C0[r+1]);b=MX3(b,C0[r+2],C0[r+3]);a=MX3(a,C1[r],C1[r+1]);b=MX3(b,C1[r+2],C1[r+3]);} \
      float rm=__builtin_fmaxf(a,b); { auto rr=__builtin_amdgcn_permlane32_swap(__float_as_uint(rm),__float_as_uint(rm),false,false); rm=__builtin_fmaxf(__uint_as_float(rr[0]),__uint_as_float(rr[1])); } \
      resc=false; \
      if(__builtin_expect(__any(rm>(float)THRL),0)){ const float dl=__builtin_fmaxf(rm,0.f); mhat+=dl; \
        _Pragma("unroll") for(int r=0;r<16;++r){C0[r]-=dl;C1[r]-=dl;} \
        const float f=__builtin_amdgcn_exp2f(-dl); l_reg*=f; if(hi==0)wsf[r32]=f; resc=true; } } \
    SBAR(); \
    GAPB(o[0]=__builtin_amdgcn_mfma_f32_32x32x16_bf16(PAF(0),VFR(0),o[0],0,0,0), C0,0); \
    GAPB(o[1]=__builtin_amdgcn_mfma_f32_32x32x16_bf16(PAF(0),VFR(4),o[1],0,0,0), C0,4); \
    KRD(GL,0); GAPB(o[0]=__builtin_amdgcn_mfma_f32_32x32x16_bf16(PAF(1),VFR(1),o[0],0,0,0), C0,8); \
    KRD(GL,1); GAPB(o[1]=__builtin_amdgcn_mfma_f32_32x32x16_bf16(PAF(1),VFR(5),o[1],0,0,0), C0,12); \
    KRD(GL,2); GAPB(o[0]=__builtin_amdgcn_mfma_f32_32x32x16_bf16(PAF(2),VFR(2),o[0],0,0,0), C1,0); \
    KRD(GL,3); GAPB(o[1]=__builtin_amdgcn_mfma_f32_32x32x16_bf16(PAF(2),VFR(6),o[1],0,0,0), C1,4); \
    GAPB(o[0]=__builtin_amdgcn_mfma_f32_32x32x16_bf16(PAF(3),VFR(3),o[0],0,0,0), C1,8); \
    GAPB(o[1]=__builtin_amdgcn_mfma_f32_32x32x16_bf16(PAF(3),VFR(7),o[1],0,0,0), C1,12); \
    }while(0)
  int t=1;
  #undef CMASK
  #define CMASK(P0,P1,t) do{}while(0)
  for(;t+5<NT;t+=2){
    STEP(pB0,pB1,pA0,pA1,t,true,true,true);     WAIT_BAR(2); RESC(); ROT();
    STEP(pA0,pA1,pB0,pB1,t+1,true,true,true);   WAIT_BAR(2); RESC(); ROT();
  }
  #undef CMASK
  #define CMASK(P0,P1,t) do{int jb_=(t)-(NT-4); if(jb_>=0)cmask(P0,P1,jb_,qrel,hi);}while(0)
  #define ENDW(tt) do{ if((tt)+3<NT){WAIT_BAR(2);} else if((tt)+2<NT){WAIT_BAR(1);} else {WAIT_BAR(0);} }while(0)
  for(;t+1<NT;t+=2){
    STEP(pB0,pB1,pA0,pA1,t,(t+3<NT),(t+1<NT),(t+1<NT));       ENDW(t);   RESC(); ROT();
    STEP(pA0,pA1,pB0,pB1,t+1,(t+4<NT),(t+2<NT),(t+2<NT));     ENDW(t+1); RESC(); ROT();
  }
  STEP(pB0,pB1,pA0,pA1,NT-1,false,false,false); RESC();
  { float sacc=pB0[0]+pB0[1]; _Pragma("unroll") for(int r=2;r<16;++r)sacc+=pB0[r]; _Pragma("unroll") for(int r=0;r<16;++r)sacc+=pB1[r]; l_reg+=sacc;
    pw0=(u32x4){PKW(pB0,0),PKW(pB0,2),PKW(pB0,4),PKW(pB0,6)};pw1=(u32x4){PKW(pB0,8),PKW(pB0,10),PKW(pB0,12),PKW(pB0,14)};pw2=(u32x4){PKW(pB1,0),PKW(pB1,2),PKW(pB1,4),PKW(pB1,6)};pw3=(u32x4){PKW(pB1,8),PKW(pB1,10),PKW(pB1,12),PKW(pB1,14)};
    SBAR(); pv(o,vb0+sl_cur,PAF(0),PAF(1),PAF(2),PAF(3)); }
  #undef PKW
  #undef PAF
  #undef VFR
  #undef PIN
  #undef MX3
  #undef GAPA
  #undef GAPB
  #undef EX
  #undef VRD
  #undef KRD
  #undef STEP
  #undef ENDW
  {auto rr=__builtin_amdgcn_permlane32_swap(__float_as_uint(l_reg),__float_as_uint(l_reg),false,false);l_reg=__uint_as_float(rr[0])+__uint_as_float(rr[1]);}
  if(hi==0)wsf[32+r32]=l_reg;asm volatile("s_waitcnt lgkmcnt(0)":::"memory");
  float rli[16];
  #pragma unroll
  for(int r=0;r<16;++r)rli[r]=__builtin_amdgcn_rcpf(wsf[32+crow(r,hi)]);
  bf16*Ow=O+(rowbase+q0+wid*QBLK)*OPITCH+h*D; const _Float16*Gw=BG+(rowbase+q0+wid*QBLK)*DM+h*D;
  { bf16*stg=(bf16*)(shm+LDS_OST)+wid*2048;
    #pragma unroll
    for(int r=0;r<16;++r){const int orow=crow(r,hi);
      #pragma unroll
      for(int d0=0;d0<2;++d0)stg[orow*64+d0*32+r32]=__float2bfloat16(o[d0][r]*rli[r]);}
    asm volatile("s_waitcnt lgkmcnt(0)":::"memory");
    #pragma unroll
    for(int i=0;i<4;++i){const int row=i*8+(lane>>3),ch=lane&7; const u32x4 v=*(const u32x4*)(stg+row*64+ch*8);
      typedef _Float16 h8_t __attribute__((ext_vector_type(8))); const h8_t gg=*(const h8_t*)(Gw+(long)row*DM+ch*8); u32x4 w;
      #pragma unroll
      for(int j=0;j<4;++j){ const float lo=__uint_as_float(v[j]<<16)*(float)gg[2*j], hi_=__uint_as_float(v[j]&0xffff0000u)*(float)gg[2*j+1]; w[j]=cvtpk_s(lo,hi_); }
      ATTN_STORE16(Ow+(long)row*OPITCH+ch*8,w);} }
  asm volatile("s_waitcnt lgkmcnt(0)\n\ts_barrier":::"memory");
  #undef DMA_K
  #undef DMA_V
  #undef CINIT
  #undef CINIT1
  #undef CMASK
  #undef START
  #undef RESC
  #undef ROT
}
constexpr int ATTN_LDS_BYTES=LDS_BYTES;
struct AttnTensors { const bf16* Q; const bf16* K; const bf16* V; bf16* O; const float* SSK; const float* CBG; const float* GQ; const float* GK; const _Float16* BG; };
struct AttnUnit { int bh; int qb; };
struct StaticOrder {
  int vcu,nmine,base;
  __device__ __forceinline__ explicit StaticOrder(int grid,int block):vcu(block),nmine(block>=128?14:2),base(block>=128?0:1792){}
  __device__ __forceinline__ bool next(int i,AttnUnit&u)const{ if(i>=nmine)return false; const int L=2047-(base+i*128+(vcu&127)); u.bh=L>>4; u.qb=L&15; return true; }
  __device__ __forceinline__ void a_ready(const AttnUnit&)const{}
  __device__ __forceinline__ void done(const AttnUnit&)const{}
};
template<class Sched,int THRL=8> __device__ __forceinline__ void attn_phase(char*lds,const AttnTensors&T,const Sched&S){
  AttnUnit u;
  for(int i=0;S.next(i,u);++i){ S.a_ready(u); attn_unit<THRL>(u.bh/NHEAD,u.bh%NHEAD,u.qb,T.Q,T.K,T.V,T.O,T.SSK,T.CBG,T.GQ,T.GK,T.BG,lds); S.done(u); }
}
#undef SBAR
#undef WAIT_BAR
}
#define DI __device__ __forceinline__
#define LAS __attribute__((address_space(3)))
typedef unsigned short u16;
typedef float f32x4 __attribute__((ext_vector_type(4)));
typedef unsigned u32x4 __attribute__((ext_vector_type(4)));
typedef unsigned u32x2 __attribute__((ext_vector_type(2)));
typedef float f32x2 __attribute__((ext_vector_type(2)));
typedef _Float16 h8 __attribute__((ext_vector_type(8)));
typedef _Float16 h4 __attribute__((ext_vector_type(4)));
typedef _Float16 h2 __attribute__((ext_vector_type(2)));
constexpr int NB = 16, SQ = 4096, DMODEL = 1024, TT = NB * SQ, DFF = 4096;
constexpr size_t MiB = 1u << 20;
constexpr size_t WS_LB = 0;
constexpr size_t WS_BAR = 65536, BAR_BYTES = 16384;
constexpr size_t WS_WIN = 1 * MiB, WS_WOUT = 9 * MiB, WS_WUP0 = 11 * MiB, WS_WUP1 = 19 * MiB, WS_WD0 = 27 * MiB, WS_WD1 = 35 * MiB,
                 WS_WBIG = 43 * MiB, WS_WLORA = 49 * MiB, WS_W2 = 56 * MiB, WS_WO = 57 * MiB;
constexpr size_t WS_LF = 60 * MiB, WS_CB = 62 * MiB, WS_SSK = 64 * MiB, WS_SS = 68 * MiB;
constexpr size_t WS_XN = 80 * MiB;
constexpr size_t WS_PROJ = 210 * MiB;
constexpr size_t WS_LH = 978 * MiB;
constexpr size_t WS_RKV = 594 * MiB;
constexpr size_t WS_WAG = 210 * MiB;
constexpr size_t WS_OA = 722 * MiB;
constexpr size_t WS_HB = 850 * MiB;
constexpr size_t WS_END = 1010 * MiB;
constexpr size_t PSTR = (size_t)TT * 512;
constexpr size_t RSTR = (size_t)TT * 1024;
constexpr int LDS_TOTAL = 147456;

typedef __bf16 bf16x2_k __attribute__((ext_vector_type(2)));
DI unsigned pk_bf16(float lo, float hi) { typedef float f2_ __attribute__((ext_vector_type(2))); const f2_ v = {lo, hi}; return __builtin_bit_cast(unsigned, __builtin_convertvector(v, bf16x2_k)); }
DI unsigned pk_f16(float lo, float hi) { h2 v = {(_Float16)lo, (_Float16)hi}; return __builtin_bit_cast(unsigned, v); }
DI float sigm(float x) { return __builtin_amdgcn_rcpf(1.0f + __expf(-x)); }
DI float bf2f(unsigned short b) { return __uint_as_float(((unsigned)b) << 16); }
template <int CTRL> DI float dpp_f(float x) { return __builtin_bit_cast(float, __builtin_amdgcn_update_dpp(0, __builtin_bit_cast(int, x), CTRL, 0xF, 0xF, true)); }
DI float red8(float x) { x += dpp_f<0xB1>(x); x += dpp_f<0x4E>(x); x += dpp_f<0x141>(x); return x; }
DI float red16(float x) { x = red8(x); x += dpp_f<0x140>(x); return x; }
DI float wave_sum(float v) {
#pragma unroll
    for (int o = 1; o < 64; o <<= 1) v += __shfl_xor(v, o);
    return v;
}
DI void st8_bf16(u16* p, const f32x4 a, const f32x4 b) { u32x4 w; w.x = pk_bf16(a[0], a[1]); w.y = pk_bf16(a[2], a[3]); w.z = pk_bf16(b[0], b[1]); w.w = pk_bf16(b[2], b[3]); *(u32x4*)p = w; }
DI void st8_bf16_nt(u16* p, const f32x4 a, const f32x4 b) { u32x4 w; w.x = pk_bf16(a[0], a[1]); w.y = pk_bf16(a[2], a[3]); w.z = pk_bf16(b[0], b[1]); w.w = pk_bf16(b[2], b[3]); __builtin_nontemporal_store(w, (u32x4*)p); }
DI void st8_f16(u16* p, const f32x4 a, const f32x4 b) { u32x4 w; w.x = pk_f16(a[0], a[1]); w.y = pk_f16(a[2], a[3]); w.z = pk_f16(b[0], b[1]); w.w = pk_f16(b[2], b[3]); *(u32x4*)p = w; }

struct EpiArgs { u16* o0; u16* o1; const float* p0; const float* p1; float* f0; float* ss; };
template <int MODE> struct Epi {
    static constexpr bool PERM = true, AFTER_DRAIN = false;
    EpiArgs a; const LAS float* rs = nullptr; mutable int ucnt = 0;
    DI void operator()(const f32x4 (&acc)[2][2][4][2], const pg8::Unit& u, int wr, int wc, int fr, int fq) const {
        const int rbase = u.pm * 256 + wr * 64 + fr;
        if constexpr (MODE == 0) {
            const int grp = u.pn >> 1, cg0 = (u.pn & 1) * 256 + wc * 32 + 8 * fq;
            u16* base = a.o0 + (size_t)grp * PSTR;
            if (grp == 5) {
                LAS float* xch = (LAS float*)rs;
                float ps[2][4][2];
#pragma unroll
                for (int ai = 0; ai < 2; ++ai)
#pragma unroll
                    for (int m = 0; m < 4; ++m)
#pragma unroll
                        for (int bj = 0; bj < 2; ++bj) { const f32x4 v0 = acc[ai][bj][m][0], v1 = acc[ai][bj][m][1];
                            float s = (v0[0] * v0[0] + v0[1] * v0[1]) + (v0[2] * v0[2] + v0[3] * v0[3]) + (v1[0] * v1[0] + v1[1] * v1[1]) + (v1[2] * v1[2] + v1[3] * v1[3]);
                            s += __shfl_xor(s, 16); s += __shfl_xor(s, 32); ps[ai][m][bj] = s;
                            if (fq == 0) xch[(ai * 128 + wr * 64 + m * 16 + fr) * 8 + bj * 4 + wc] = s; }
                asm volatile("s_waitcnt lgkmcnt(0)" ::: "memory"); __builtin_amdgcn_s_barrier(); asm volatile("" ::: "memory");
                const f32x4 gk0 = *(const f32x4*)(a.p1 + (wc & 1) * 32 + 8 * fq), gk1 = *(const f32x4*)(a.p1 + (wc & 1) * 32 + 8 * fq + 4);
#pragma unroll
                for (int ai = 0; ai < 2; ++ai)
#pragma unroll
                    for (int m = 0; m < 4; ++m) { const int row = rbase + ai * 128 + m * 16;
#pragma unroll
                        for (int bj = 0; bj < 2; ++bj) { const float tot = ps[ai][m][bj] + xch[(ai * 128 + wr * 64 + m * 16 + fr) * 8 + bj * 4 + (wc ^ 1)];
                            const float rstd = rsqrtf(tot * (1.0f / 64.0f) + 1e-6f);
                            st8_bf16(base + (size_t)row * 512 + cg0 + bj * 128, acc[ai][bj][m][0] * rstd * gk0, acc[ai][bj][m][1] * rstd * gk1); } }
                return;
            }
            f32x4 lb[2][2];
#pragma unroll
            for (int bj = 0; bj < 2; ++bj) { lb[bj][0] = *(const f32x4*)(a.p0 + cg0 + bj * 128); lb[bj][1] = *(const f32x4*)(a.p0 + cg0 + bj * 128 + 4); }
#pragma unroll
            for (int ai = 0; ai < 2; ++ai)
#pragma unroll
                for (int m = 0; m < 4; ++m) {
                    const int row = rbase + ai * 128 + m * 16;
#pragma unroll
                    for (int bj = 0; bj < 2; ++bj) {
                        f32x4 v0 = acc[ai][bj][m][0], v1 = acc[ai][bj][m][1];
                        u16* dst = base + (size_t)row * 512 + cg0 + bj * 128;
                        if (grp == 0 || grp == 3) {
#pragma unroll
                            for (int j = 0; j < 4; ++j) { v0[j] = v0[j] * sigm(v0[j]); v1[j] = v1[j] * sigm(v1[j]); }
                            st8_f16(dst, v0, v1);
                        } else if (grp == 1) {
#pragma unroll
                            for (int j = 0; j < 4; ++j) { v0[j] = lb[bj][0][j] + (1.0f - lb[bj][0][j]) * sigm(v0[j]); v1[j] = lb[bj][1][j] + (1.0f - lb[bj][1][j]) * sigm(v1[j]); }
                            st8_f16(dst, v0, v1);
                        } else if (grp == 2) { st8_f16(dst, v0, v1);
                        } else if (grp == 7) {
#pragma unroll
                            for (int j = 0; j < 4; ++j) { v0[j] = sigm(v0[j]); v1[j] = sigm(v1[j]); }
                            st8_f16(dst, v0, v1);
                        } else {
                            st8_bf16(dst, v0, v1);
                        }
                    }
                }
        } else if constexpr (MODE == 1) {
            const int col = u.pn * 256 + wc * 32 + 8 * fq;
#pragma unroll
            for (int ai = 0; ai < 2; ++ai) {
                f32x4 r0[4][2], r1[4][2];
                if (a.p0) {
#pragma unroll
                    for (int m = 0; m < 4; ++m)
#pragma unroll
                        for (int bj = 0; bj < 2; ++bj) { const size_t off = (size_t)(rbase + ai * 128 + m * 16) * 1024 + col + bj * 128; r0[m][bj] = *(const f32x4*)(a.p0 + off); r1[m][bj] = *(const f32x4*)(a.p0 + off + 4); }
                } else {
                    u32x4 w[4][2];
#pragma unroll
                    for (int m = 0; m < 4; ++m)
#pragma unroll
                        for (int bj = 0; bj < 2; ++bj) w[m][bj] = *(const u32x4*)(a.o1 + (size_t)(rbase + ai * 128 + m * 16) * 1024 + col + bj * 128);
#pragma unroll
                    for (int m = 0; m < 4; ++m)
#pragma unroll
                        for (int bj = 0; bj < 2; ++bj) { const u32x4 q = w[m][bj];
                            r0[m][bj] = (f32x4){__uint_as_float(q.x << 16), __uint_as_float(q.x & 0xffff0000u), __uint_as_float(q.y << 16), __uint_as_float(q.y & 0xffff0000u)};
                            r1[m][bj] = (f32x4){__uint_as_float(q.z << 16), __uint_as_float(q.z & 0xffff0000u), __uint_as_float(q.w << 16), __uint_as_float(q.w & 0xffff0000u)}; }
                }
#pragma unroll
                for (int m = 0; m < 4; ++m) {
                    const int row = rbase + ai * 128 + m * 16; float s = 0.f;
#pragma unroll
                    for (int bj = 0; bj < 2; ++bj) {
                        const size_t off = (size_t)row * 1024 + col + bj * 128;
                        const f32x4 v0 = acc[ai][bj][m][0] + r0[m][bj], v1 = acc[ai][bj][m][1] + r1[m][bj];
                        if (a.f0) { *(f32x4*)(a.f0 + off) = v0; *(f32x4*)(a.f0 + off + 4) = v1; }
                        if (a.o0) st8_bf16(a.o0 + off, v0, v1);
                        s += (v0[0] * v0[0] + v0[1] * v0[1]) + (v0[2] * v0[2] + v0[3] * v0[3]) + (v1[0] * v1[0] + v1[1] * v1[1]) + (v1[2] * v1[2] + v1[3] * v1[3]);
                    }
                    if (a.ss) { s += __shfl_xor(s, 16); s += __shfl_xor(s, 32); if (fq == 0) a.ss[(size_t)row * 16 + u.pn * 4 + wc] = s; }
                }
            }
        } else if constexpr (MODE == 2) {
            const int col = u.pn * 256 + wc * 32 + 8 * fq;
#pragma unroll
            for (int ai = 0; ai < 2; ++ai)
#pragma unroll
                for (int m = 0; m < 4; ++m) {
                    const int row = rbase + ai * 128 + m * 16;
                    const float rstd = rs[(ucnt & 1) * 256 + ai * 128 + wr * 64 + m * 16 + fr];
#pragma unroll
                    for (int bj = 0; bj < 2; ++bj) {
                        f32x4 v0 = acc[ai][bj][m][0], v1 = acc[ai][bj][m][1];
#pragma unroll
                        for (int j = 0; j < 4; ++j) { float t0 = fmaxf(v0[j], 0.f) * rstd, t1 = fmaxf(v1[j], 0.f) * rstd; v0[j] = t0 * t0; v1[j] = t1 * t1; }
                        st8_bf16(a.o0 + (size_t)row * 4096 + col + bj * 128, v0, v1);
                    }
                }
            ++ucnt;
        } else if constexpr (MODE == 3 || MODE == 5) {
#pragma unroll
            for (int ai = 0; ai < 2; ++ai)
#pragma unroll
                for (int m = 0; m < 4; ++m) {
                    const int row = rbase + ai * 128 + m * 16;
#pragma unroll
                    for (int bj = 0; bj < 2; ++bj) {
                        f32x4 v0 = acc[ai][bj][m][0], v1 = acc[ai][bj][m][1];
                        if (MODE == 3) { st8_f16(a.o0 + (size_t)(u.pn >> 2) * RSTR + (size_t)row * 1024 + (u.pn & 3) * 256 + bj * 128 + wc * 32 + 8 * fq, v0, v1); }
                        else {
                            if (bj == 1) {
#pragma unroll
                                for (int j = 0; j < 4; ++j) { v0[j] = sigm(v0[j]); v1[j] = sigm(v1[j]); }
                            } else if (wc < 2) {
#pragma unroll
                                for (int j = 0; j < 4; ++j) { v0[j] = 1.0f - 2.0f * __builtin_amdgcn_rcpf(__expf(2.0f * v0[j]) + 1.0f); v1[j] = 1.0f - 2.0f * __builtin_amdgcn_rcpf(__expf(2.0f * v1[j]) + 1.0f); }
                            }
                            st8_bf16(a.o1 + (size_t)row * 256 + bj * 128 + wc * 32 + 8 * fq, v0, v1);
                        }
                    }
                }
        } else if constexpr (MODE == 4) {
            const int grp = u.pn >> 2, c0 = (u.pn & 3) * 256 + wc * 32 + 8 * fq;
            const float* bias = grp == 0 ? a.p0 : a.p1;
#pragma unroll
            for (int ai = 0; ai < 2; ++ai)
#pragma unroll
                for (int m = 0; m < 4; ++m) {
                    const int row = rbase + ai * 128 + m * 16;
#pragma unroll
                    for (int bj = 0; bj < 2; ++bj) {
                        f32x4 bv[2][2]; bv[bj][0] = *(const f32x4*)(bias + c0 + bj * 128); bv[bj][1] = *(const f32x4*)(bias + c0 + bj * 128 + 4);
                        f32x4 v0 = acc[ai][bj][m][0], v1 = acc[ai][bj][m][1]; if (grp < 2) { v0 = v0 + bv[bj][0]; v1 = v1 + bv[bj][1]; }
                        asm volatile("" : "+v"(v0), "+v"(v1));
                        if (grp == 0) {
#pragma unroll
                            for (int j = 0; j < 4; ++j) { v0[j] = __expf(-0.60653066f * sigm(v0[j])); v1[j] = __expf(-0.60653066f * sigm(v1[j])); }
                        } else if (grp == 1) {
#pragma unroll
                            for (int j = 0; j < 4; ++j) { v0[j] = sigm(v0[j]); v1[j] = sigm(v1[j]); }
                        }
                        st8_f16(a.o0 + (size_t)grp * RSTR + (size_t)row * 1024 + c0 + bj * 128, v0, v1);
                    }
                }
        }
    }
};
DI void tr_item(const float* __restrict__ W, int ldw, int col0w, int Nn, u16* WT, int ldt, int row_off, int kcol_off, const float* __restrict__ sc, int scmode, LAS float* scr, int item, int lane) {
    const int nblk = Nn / 32, kb = item / nblk, nb = item % nblk, k0 = 64 * kb, n0 = 32 * nb;
#pragma unroll 8
    for (int i = 0; i < 32; ++i) { const int kk = 2 * i + (lane >> 5); float s = 1.0f; if (scmode == 1) s = sc[k0 + kk]; else if (scmode == 2) s = 1.0f - sc[k0 + kk];
        scr[kk * 33 + (lane & 31)] = W[(size_t)(k0 + kk) * ldw + col0w + n0 + (lane & 31)] * s; }
    asm volatile("s_waitcnt lgkmcnt(0)" ::: "memory");
    const int c = lane & 7;
#pragma unroll
    for (int j = 0; j < 4; ++j) { const int n = (lane >> 3) + 8 * j; const LAS float* s = scr + (8 * c) * 33 + n;
        u32x4 o; o.x = pk_bf16(s[0 * 33], s[1 * 33]); o.y = pk_bf16(s[2 * 33], s[3 * 33]); o.z = pk_bf16(s[4 * 33], s[5 * 33]); o.w = pk_bf16(s[6 * 33], s[7 * 33]);
        *(u32x4*)(WT + (size_t)(row_off + n0 + n) * ldt + kcol_off + k0 + 8 * c) = o; }
    asm volatile("s_waitcnt lgkmcnt(0)" ::: "memory");
}

struct Args { const float* in[28]; float* out; unsigned char* ws; };

DI void p0_prologue(const Args& A, LAS unsigned char* lds, int tid, int lane, int wave) {
    unsigned char* ws = A.ws;
    LAS float* scr = (LAS float*)(lds + wave * 16384);
    const int gw = blockIdx.x * 8 + wave, NGW = gridDim.x * 8;
    u16* WIN = (u16*)(ws + WS_WIN); u16* WOUT = (u16*)(ws + WS_WOUT); u16* WUP0 = (u16*)(ws + WS_WUP0); u16* WUP1 = (u16*)(ws + WS_WUP1);
    u16* WD0 = (u16*)(ws + WS_WD0); u16* WD1 = (u16*)(ws + WS_WD1); u16* WBIG = (u16*)(ws + WS_WBIG); u16* WLORA = (u16*)(ws + WS_WLORA); u16* W2 = (u16*)(ws + WS_W2); u16* WO = (u16*)(ws + WS_WO);
    const float* mu = A.in[10];
    constexpr int I_IN = 16 * 128, I_SQ = 16 * 32, I_UP = 16 * 128, I_DN = 64 * 32, I_L64 = 16 * 2, I_L128 = 16 * 4, I_W2 = 32, I_G2 = 64;
    constexpr int NITEMS = I_IN + I_SQ + 2 * I_UP + 2 * I_DN + 3 * I_SQ + 4 * I_L64 + 2 * I_L128 + 2 * I_W2 + I_G2 + I_SQ;
    for (int it = gw; it < NITEMS; it += NGW) {
        int r = it;
        if (r < I_IN) { tr_item(A.in[3], 4104, 0, 4096, WIN, 1024, 0, 0, nullptr, 0, scr, r, lane); continue; } r -= I_IN;
        if (r < I_SQ) { tr_item(A.in[9], 1024, 0, 1024, WOUT, 1024, 0, 0, nullptr, 0, scr, r, lane); continue; } r -= I_SQ;
        if (r < I_UP) { tr_item(A.in[26], 4096, 0, 4096, WUP0, 1024, 0, 0, A.in[2], 1, scr, r, lane); continue; } r -= I_UP;
        if (r < I_UP) { tr_item(A.in[26] + (size_t)1024 * 4096, 4096, 0, 4096, WUP1, 1024, 0, 0, A.in[2] + 1024, 1, scr, r, lane); continue; } r -= I_UP;
        if (r < I_DN) { tr_item(A.in[27], 1024, 0, 1024, WD0, 4096, 0, 0, nullptr, 0, scr, r, lane); continue; } r -= I_DN;
        if (r < I_DN) { tr_item(A.in[27] + (size_t)4096 * 1024, 1024, 0, 1024, WD1, 4096, 0, 0, nullptr, 0, scr, r, lane); continue; } r -= I_DN;
        if (r < 3 * I_SQ) { const int i3 = r / I_SQ;
            tr_item(A.in[11] + (size_t)i3 * 1024 * 1024, 1024, 0, 1024, WBIG, 1024, i3 * 1024, 0, nullptr, 0, scr, r % I_SQ, lane); continue; } r -= 3 * I_SQ;
        if (r < 2 * I_L64) { const int half = r / I_L64; tr_item(A.in[13], 64, 0, 64, WLORA, 2048, 0, half * 1024, mu + 1 * 1024, half ? 1 : 2, scr, r % I_L64, lane); continue; } r -= 2 * I_L64;
        if (r < 2 * I_L64) { const int half = r / I_L64; tr_item(A.in[16], 64, 0, 64, WLORA, 2048, 64, half * 1024, mu + 4 * 1024, half ? 1 : 2, scr, r % I_L64, lane); continue; } r -= 2 * I_L64;
        if (r < 2 * I_L128) { const int half = r / I_L128; tr_item(A.in[18], 128, 0, 128, WLORA, 2048, 128, half * 1024, mu + 5 * 1024, half ? 1 : 2, scr, r % I_L128, lane); continue; } r -= 2 * I_L128;
        if (r < I_W2) { tr_item(A.in[14], 1024, 0, 1024, W2, 128, 0, 0, nullptr, 0, scr, r, lane); continue; } r -= I_W2;
        if (r < I_W2) { tr_item(A.in[17], 1024, 0, 1024, W2, 128, 1024, 0, nullptr, 0, scr, r, lane); continue; } r -= I_W2;
        if (r < I_G2) { tr_item(A.in[19], 1024, 0, 1024, W2, 128, 2048, 0, nullptr, 0, scr, r, lane); continue; } r -= I_G2;
        tr_item(A.in[25], 1024, 0, 1024, WO, 1024, 0, 0, nullptr, 0, scr, r, lane);
    }
    for (int i = blockIdx.x * 512 + tid; i < 2048 * 8; i += gridDim.x * 512) { const int n = i >> 3, c = i & 7; *(u32x4*)(W2 + (size_t)n * 128 + 64 + c * 8) = (u32x4){0u, 0u, 0u, 0u}; }
    if (blockIdx.x == 0) { const float* G = A.in[4]; float* LB = (float*)(ws + WS_LB); const int c = tid;
        const float g0 = G[c], g1 = G[512 + c], g2 = G[1024 + c], mx = fmaxf(g0, fmaxf(g1, g2)); const float e0 = __expf(g0 - mx), e1 = __expf(g1 - mx), e2 = __expf(g2 - mx); LB[c] = e0 / (e0 + e1 + e2); }
    {
        const float* x = A.in[0]; const float* g = A.in[1]; const float* win = A.in[3]; const float* fb = A.in[6];
        u16* XN = (u16*)(ws + WS_XN); float* LF = (float*)(ws + WS_LF);
        f32x4 gv[4], wv0[4][4], wv1[4][4];
#pragma unroll
        for (int j = 0; j < 4; ++j) { gv[j] = *(const f32x4*)(g + 4 * lane + 256 * j);
#pragma unroll
            for (int e = 0; e < 4; ++e) { const float* wr_ = win + (size_t)(4 * lane + 256 * j + e) * 4104 + 4096; wv0[j][e] = *(const f32x4*)wr_; wv1[j][e] = *(const f32x4*)(wr_ + 4); } }
        asm volatile("" ::: "memory");
        for (int m = gw; m < TT; m += NGW) {
            const f32x4* xr = (const f32x4*)(x + (size_t)m * 1024) + lane;
            f32x4 v[4]; float s = 0.f;
#pragma unroll
            for (int j = 0; j < 4; ++j) { v[j] = xr[64 * j]; s += (v[j][0] * v[j][0] + v[j][1] * v[j][1]) + (v[j][2] * v[j][2] + v[j][3] * v[j][3]); }
            const float rstd = rsqrtf(wave_sum(s) * (1.0f / 1024.0f) + 1e-6f);
            float pf[8];
#pragma unroll
            for (int q = 0; q < 8; ++q) pf[q] = 0.f;
            u32x2* o8 = (u32x2*)(XN + (size_t)m * 1024) + lane;
#pragma unroll
            for (int j = 0; j < 4; ++j) { v[j] = v[j] * rstd * gv[j]; u32x2 w; w.x = pk_bf16(v[j][0], v[j][1]); w.y = pk_bf16(v[j][2], v[j][3]); o8[64 * j] = w;
#pragma unroll
                for (int e = 0; e < 4; ++e) { const f32x4 w0 = wv0[j][e], w1 = wv1[j][e];
                    pf[0] += v[j][e] * w0[0]; pf[1] += v[j][e] * w0[1]; pf[2] += v[j][e] * w0[2]; pf[3] += v[j][e] * w0[3]; pf[4] += v[j][e] * w1[0]; pf[5] += v[j][e] * w1[1]; pf[6] += v[j][e] * w1[2]; pf[7] += v[j][e] * w1[3]; } }
#pragma unroll
            for (int q = 0; q < 8; ++q) pf[q] = wave_sum(pf[q]);
            if (lane < 8) { float z = pf[0];
#pragma unroll
                for (int q = 1; q < 8; ++q) z = (lane == q) ? pf[q] : z;
                z += fb[lane]; LF[(size_t)m * 8 + lane] = fminf(z, 0.f) - log1pf(__expf(-fabsf(z))); }
        }
    }
}

DI void fox_cumsum(const Args& A, LAS unsigned char* lds, int bh, int tid, int lane, int wave) {
    const float* LF = (const float*)(A.ws + WS_LF); float* CB = (float*)(A.ws + WS_CB);
    const int b = bh >> 3, h = bh & 7; LAS float* tot = (LAS float*)lds;
    float v[8]; float run = 0.f;
#pragma unroll
    for (int i = 0; i < 8; ++i) { run += LF[((size_t)b * SQ + tid * 8 + i) * 8 + h]; v[i] = run; }
    float inc = run;
#pragma unroll
    for (int o = 1; o < 64; o <<= 1) { const float t = __shfl_up(inc, o); if (lane >= o) inc += t; }
    if (lane == 63) tot[wave] = inc;
    __syncthreads();
    float off = inc - run;
    for (int w = 0; w < wave; ++w) off += tot[w];
#pragma unroll
    for (int i = 0; i < 8; ++i) CB[(size_t)bh * SQ + tid * 8 + i] = -(v[i] + off) * 1.4426950408889634f;
    __syncthreads();
}

DI void hgrn_phase(const Args& A, LAS unsigned char* lds, int tid, int lane, int wave) {
    const int blk = blockIdx.x; if (blk >= 256) return;
    const int bh = blk >> 2, dq = blk & 3, b = bh >> 2, h = bh & 3;
    const _Float16* AQ = (const _Float16*)(A.ws + WS_PROJ); const _Float16* FF = AQ + PSTR; const _Float16* AI = AQ + 2 * PSTR;
    float* OA = (float*)(A.ws + WS_OA);
    LAS float* QL = (LAS float*)lds; LAS float* FL = QL + 64 * 128; LAS float* VL = FL + 64 * 128; LAS float* OL = VL + 64 * 32;
    const int dvl = lane >> 4, dkg = lane & 15, dvi = wave * 4 + dvl;
    const size_t row0 = (size_t)b * SQ;
    f32x2 S2[4];
#pragma unroll
    for (int i = 0; i < 4; ++i) S2[i] = (f32x2){0.f, 0.f};
    h8 pq[2], pf[2]; h4 pv;
    const int e0 = tid * 8;
    const int vt = tid >> 3, vo = (tid & 7) * 4;
#define HG_LOAD(c) do { _Pragma("unroll") for (int i = 0; i < 2; ++i) { const int e = e0 + i * 4096, t = e >> 7, dk = e & 127; const size_t g = (row0 + (size_t)(c) * 64 + t) * 512 + h * 128 + dk; pq[i] = *(const h8*)(AQ + g); pf[i] = *(const h8*)(FF + g); } \
        pv = *(const h4*)(AI + (row0 + (size_t)(c) * 64 + vt) * 512 + h * 128 + dq * 32 + vo); } while (0)
    HG_LOAD(0);
    for (int c = 0; c < 64; ++c) {
        __syncthreads();
#pragma unroll
        for (int i = 0; i < 2; ++i) { const int e = e0 + i * 4096;
            f32x4 a0, a1, b0, b1;
#pragma unroll
            for (int j = 0; j < 4; ++j) { a0[j] = (float)pq[i][j]; a1[j] = (float)pq[i][4 + j]; b0[j] = (float)pf[i][j]; b1[j] = (float)pf[i][4 + j]; }
            *(LAS f32x4*)(QL + e) = a0; *(LAS f32x4*)(QL + e + 4) = a1; *(LAS f32x4*)(FL + e) = b0; *(LAS f32x4*)(FL + e + 4) = b1; }
        { f32x4 vv; vv[0] = (float)pv[0]; vv[1] = (float)pv[1]; vv[2] = (float)pv[2]; vv[3] = (float)pv[3]; *(LAS f32x4*)(VL + vt * 32 + vo) = vv; }
        __syncthreads();
        if (c + 1 < 64) HG_LOAD(c + 1);
        f32x4 nf0 = *(const LAS f32x4*)(FL + dkg * 8), nf1 = *(const LAS f32x4*)(FL + dkg * 8 + 4), nq0 = *(const LAS f32x4*)(QL + dkg * 8), nq1 = *(const LAS f32x4*)(QL + dkg * 8 + 4);
        float nvv = VL[dvi];
#pragma unroll 4
        for (int t = 0; t < 64; ++t) {
            const f32x4 f0 = nf0, f1 = nf1, q0 = nq0, q1 = nq1; const float vv = nvv;
            { const int o = ((t + 1) & 63) * 128 + dkg * 8;
              nf0 = *(const LAS f32x4*)(FL + o); nf1 = *(const LAS f32x4*)(FL + o + 4); nq0 = *(const LAS f32x4*)(QL + o); nq1 = *(const LAS f32x4*)(QL + o + 4); nvv = VL[((t + 1) & 63) * 32 + dvi]; }
            const f32x2 v2 = {vv, vv};
            S2[0] = (f32x2){f0[0], f0[1]} * (S2[0] - v2) + v2; S2[1] = (f32x2){f0[2], f0[3]} * (S2[1] - v2) + v2;
            S2[2] = (f32x2){f1[0], f1[1]} * (S2[2] - v2) + v2; S2[3] = (f32x2){f1[2], f1[3]} * (S2[3] - v2) + v2;
            f32x2 op = S2[0] * (f32x2){q0[0], q0[1]} + S2[1] * (f32x2){q0[2], q0[3]}; op = op + (S2[2] * (f32x2){q1[0], q1[1]} + S2[3] * (f32x2){q1[2], q1[3]});
            const float o = red16(op.x + op.y);
            if (dkg == 0) OL[t * 32 + dvi] = o;
        }
        __syncthreads();
        { const f32x4 ov = *(const LAS f32x4*)(OL + vt * 32 + vo); *(f32x4*)(OA + (row0 + (size_t)c * 64 + vt) * 512 + h * 128 + dq * 32 + vo) = ov; }
    }
#undef HG_LOAD
    __syncthreads();
}

DI u16 f2bf(float f) { const unsigned u = __float_as_uint(f); return (u16)((u + 0x7fffu + ((u >> 16) & 1u)) >> 16); }
DI void hgrn_mfma_phase(const Args& A, LAS unsigned char* lds, int tid, int lane, int wave) {
    typedef short bfx8 __attribute__((ext_vector_type(8)));
    const int bh = blockIdx.x >> 1, half = blockIdx.x & 1, b = bh >> 2, h = bh & 3;
    const _Float16* AQ = (const _Float16*)(A.ws + WS_PROJ); const _Float16* FF = AQ + PSTR; const _Float16* AI = AQ + 2 * PSTR;
    float* OA = (float*)(A.ws + WS_OA);
    LAS _Float16* QH = (LAS _Float16*)lds; LAS _Float16* FH = QH + 64 * 128; LAS u16* AS = (LAS u16*)lds;
    LAS u16* Qt = (LAS u16*)(lds + 32768); LAS u16* Kt = Qt + 64 * 136; LAS u16* KhT = Kt + 64 * 136; LAS u16* VT = KhT + 128 * 72; LAS u16* ST = VT + 128 * 72;
    LAS float* EBL = (LAS float*)(ST + 128 * 136); LAS float* SEG = EBL + 128; LAS float* NS = SEG + 512;
    const size_t row0 = (size_t)b * SQ;
    const int l16 = lane & 15, lq = lane >> 4;
    const _Float16* AGp = (const _Float16*)(A.ws + WS_PROJ) + 3 * PSTR; u16* Y = (u16*)(A.ws + WS_XN);
    f32x4 gnv[4]; h4 pg[4];
#pragma unroll
    for (int j = 0; j < 4; ++j) gnv[j] = *(const f32x4*)(A.in[5] + h * 128 + 16 * ((wave & 1) * 4 + j) + 4 * lq);
    for (int i = tid; i < 128 * 136 / 2; i += 512) ((LAS unsigned*)ST)[i] = 0u;
    f32x4 Sacc[8];
#pragma unroll
    for (int j = 0; j < 8; ++j) Sacc[j] = (f32x4){0.f, 0.f, 0.f, 0.f};
    h8 pq[2], pf[2], pv[2];
    const int e0 = tid * 8;
    const int cd = tid & 127, tq = tid >> 7;
#define HG_LOAD(c) do { _Pragma("unroll") for (int i = 0; i < 2; ++i) { const int e = e0 + i * 4096, t = e >> 7, dk = e & 127; const size_t g = (row0 + (size_t)(c) * 64 + t) * 512 + h * 128 + dk; pq[i] = *(const h8*)(AQ + g); pf[i] = *(const h8*)(FF + g); pv[i] = *(const h8*)(AI + g); } } while (0)
    const int c_out = half ? 32 : 0, c_end = half ? 64 : 32; int cs = c_out;
    if (half) {
        float accd = 1.0f;
        while (cs > 0) {
            const int j = cs - 1;
#pragma unroll
            for (int i = 0; i < 2; ++i) { const int e = e0 + i * 4096, t = e >> 7, dk = e & 127; *(LAS h8*)(FH + e) = *(const h8*)(FF + (row0 + (size_t)j * 64 + t) * 512 + h * 128 + dk); }
            __syncthreads();
            float run = 1.0f;
#pragma unroll
            for (int i = 0; i < 16; ++i) run *= (float)FH[(16 * tq + i) * 128 + cd];
            SEG[tq * 128 + cd] = run;
            __syncthreads();
            accd *= (SEG[cd] * SEG[128 + cd]) * (SEG[256 + cd] * SEG[384 + cd]);
            float m = accd;
#pragma unroll
            for (int o_ = 1; o_ < 64; o_ <<= 1) m = fmaxf(m, __shfl_xor(m, o_));
            if (lane == 0) NS[wave] = m;
            __syncthreads();
            float mx = NS[0];
#pragma unroll
            for (int w_ = 1; w_ < 8; ++w_) mx = fmaxf(mx, NS[w_]);
            cs = j;
            __syncthreads();
            if (mx < 2.8e-14f) break;
        }
    }
    HG_LOAD(cs);
    for (int c = cs; c < c_end; ++c) {
        const bool emit = (c >= c_out);
#pragma unroll
        for (int i = 0; i < 2; ++i) { const int e = e0 + i * 4096, t = e >> 7, dv = e & 127; *(LAS h8*)(QH + e) = pq[i]; *(LAS h8*)(FH + e) = pf[i];
#pragma unroll
            for (int j = 0; j < 8; j += 2) { const unsigned vw = pk_bf16((float)pv[i][j], (float)pv[i][j + 1]); VT[(dv + j) * 72 + t] = (u16)vw; VT[(dv + j + 1) * 72 + t] = (u16)(vw >> 16); } }
        __syncthreads();
        if (c + 1 < c_end) HG_LOAD(c + 1);
#pragma unroll
        for (int j = 0; j < 4; ++j) pg[j] = *(const h4*)(AGp + (row0 + (size_t)c * 64 + 16 * (wave >> 1) + l16) * 512 + h * 128 + 16 * ((wave & 1) * 4 + j) + 4 * lq);
        float cs[16], kq[16]; float run = 1.0f;
#pragma unroll
        for (int i = 0; i < 16; ++i) { const float f = (float)FH[(16 * tq + i) * 128 + cd]; kq[i] = 1.0f - f; run *= f; cs[i] = run; }
        SEG[tq * 128 + cd] = run;
        __syncthreads();
        { const float s0 = SEG[cd], s1 = SEG[128 + cd], s2 = SEG[256 + cd], s3 = SEG[384 + cd];
          const float off = (tq > 0 ? s0 : 1.0f) * (tq > 1 ? s1 : 1.0f) * (tq > 2 ? s2 : 1.0f), ebl = (s0 * s1) * (s2 * s3);
          unsigned khw[8];
#pragma unroll
          for (int i = 0; i < 16; i += 2) { const int t = 16 * tq + i; const float q0 = (float)QH[t * 128 + cd], q1 = (float)QH[(t + 1) * 128 + cd];
              const float x0 = cs[i] * off, x1 = cs[i + 1] * off, k0 = kq[i] * __builtin_amdgcn_rcpf(x0), k1 = kq[i + 1] * __builtin_amdgcn_rcpf(x1);
              const unsigned qw = pk_bf16(q0 * x0, q1 * x1), kw = pk_bf16(k0, k1);
              Qt[t * 136 + cd] = (u16)qw; Qt[(t + 1) * 136 + cd] = (u16)(qw >> 16); Kt[t * 136 + cd] = (u16)kw; Kt[(t + 1) * 136 + cd] = (u16)(kw >> 16);
              khw[i >> 1] = pk_bf16(k0 * ebl, k1 * ebl); }
          if (tq == 0) EBL[cd] = ebl;
          *(LAS u32x4*)(KhT + cd * 72 + 16 * tq) = (u32x4){khw[0], khw[1], khw[2], khw[3]}; *(LAS u32x4*)(KhT + cd * 72 + 16 * tq + 8) = (u32x4){khw[4], khw[5], khw[6], khw[7]}; }
        __syncthreads();
        { const int tt = wave >> 1;
#pragma unroll
          for (int j = 0; j < 2; ++j) { const int st = (wave & 1) * 2 + j; f32x4 acc = (f32x4){0.f, 0.f, 0.f, 0.f};
              if (st <= tt) {
#pragma unroll
                  for (int kk = 0; kk < 4; ++kk) { const bfx8 X = *(const LAS bfx8*)(Kt + (16 * st + l16) * 136 + 32 * kk + 8 * lq), Y = *(const LAS bfx8*)(Qt + (16 * tt + l16) * 136 + 32 * kk + 8 * lq);
                      acc = __builtin_amdgcn_mfma_f32_16x16x32_bf16(X, Y, acc, 0, 0, 0); } }
              const int t = 16 * tt + l16, s = 16 * st + 4 * lq; u32x2 w;
              w.x = pk_bf16(s + 0 <= t ? acc[0] : 0.f, s + 1 <= t ? acc[1] : 0.f); w.y = pk_bf16(s + 2 <= t ? acc[2] : 0.f, s + 3 <= t ? acc[3] : 0.f);
              *(LAS u32x2*)(AS + t * 72 + s) = w; } }
        __syncthreads();
        f32x4 oacc[4];
        { const int tt = wave >> 1; bfx8 ya[2], yq[4];
#pragma unroll
          for (int kk = 0; kk < 2; ++kk) ya[kk] = *(const LAS bfx8*)(AS + (16 * tt + l16) * 72 + 32 * kk + 8 * lq);
#pragma unroll
          for (int kk = 0; kk < 4; ++kk) yq[kk] = *(const LAS bfx8*)(Qt + (16 * tt + l16) * 136 + 32 * kk + 8 * lq);
#pragma unroll
          for (int j = 0; j < 4; ++j) { const int vt = (wave & 1) * 4 + j; f32x4 acc = (f32x4){0.f, 0.f, 0.f, 0.f};
#pragma unroll
              for (int kk = 0; kk < 2; ++kk) acc = __builtin_amdgcn_mfma_f32_16x16x32_bf16(*(const LAS bfx8*)(VT + (16 * vt + l16) * 72 + 32 * kk + 8 * lq), ya[kk], acc, 0, 0, 0);
#pragma unroll
              for (int kk = 0; kk < 4; ++kk) acc = __builtin_amdgcn_mfma_f32_16x16x32_bf16(*(const LAS bfx8*)(ST + (16 * vt + l16) * 136 + 32 * kk + 8 * lq), yq[kk], acc, 0, 0, 0);
              oacc[j] = acc; }
          { float s_ = 0.f;
#pragma unroll
            for (int j = 0; j < 4; ++j) s_ += (oacc[j][0] * oacc[j][0] + oacc[j][1] * oacc[j][1]) + (oacc[j][2] * oacc[j][2] + oacc[j][3] * oacc[j][3]);
            s_ += __shfl_xor(s_, 16); s_ += __shfl_xor(s_, 32);
            if (lq == 0) NS[(16 * tt + l16) * 2 + (wave & 1)] = s_; }
          const bfx8 xv0 = *(const LAS bfx8*)(VT + (16 * wave + l16) * 72 + 8 * lq), xv1 = *(const LAS bfx8*)(VT + (16 * wave + l16) * 72 + 32 + 8 * lq);
#pragma unroll
          for (int dt = 0; dt < 8; ++dt) { const float dec = EBL[16 * dt + l16]; f32x4 sa = Sacc[dt] * dec;
              sa = __builtin_amdgcn_mfma_f32_16x16x32_bf16(xv0, *(const LAS bfx8*)(KhT + (16 * dt + l16) * 72 + 8 * lq), sa, 0, 0, 0);
              sa = __builtin_amdgcn_mfma_f32_16x16x32_bf16(xv1, *(const LAS bfx8*)(KhT + (16 * dt + l16) * 72 + 32 + 8 * lq), sa, 0, 0, 0);
              Sacc[dt] = sa; } }
        __syncthreads();
        { const int tt = wave >> 1; const float rstd = rsqrtf((NS[(16 * tt + l16) * 2] + NS[(16 * tt + l16) * 2 + 1]) * (1.0f / 128.0f) + 1e-6f);
          const size_t grow = row0 + (size_t)c * 64 + 16 * tt + l16;
          if (emit)
#pragma unroll
          for (int j = 0; j < 4; ++j) { const int vcol = h * 128 + 16 * ((wave & 1) * 4 + j) + 4 * lq; const h4 gt = pg[j];
              u32x2 w_; w_.x = pk_bf16(oacc[j][0] * rstd * gnv[j][0] * (float)gt[0], oacc[j][1] * rstd * gnv[j][1] * (float)gt[1]); w_.y = pk_bf16(oacc[j][2] * rstd * gnv[j][2] * (float)gt[2], oacc[j][3] * rstd * gnv[j][3] * (float)gt[3]);
              *(u32x2*)(Y + grow * 1024 + vcol) = w_; } }
#pragma unroll
        for (int dt = 0; dt < 8; ++dt)
#pragma unroll
            for (int r = 0; r < 4; r += 2) { const unsigned sw = pk_bf16(Sacc[dt][r], Sacc[dt][r + 1]); ST[(16 * wave + 4 * lq + r) * 136 + 16 * dt + l16] = (u16)sw; ST[(16 * wave + 4 * lq + r + 1) * 136 + 16 * dt + l16] = (u16)(sw >> 16); }
    }
#undef HG_LOAD
    __syncthreads();
}

DI void hgrn_norm_phase(const Args& A, int lane, int wave) {
    const float* OA = (const float*)(A.ws + WS_OA); const _Float16* AG = (const _Float16*)(A.ws + WS_PROJ) + 3 * PSTR; const float* gn = A.in[5];
    u16* Y = (u16*)(A.ws + WS_XN);
    const int gw = blockIdx.x * 8 + wave, NGW = gridDim.x * 8, c0 = lane * 8;
    const f32x4 g0 = *(const f32x4*)(gn + c0), g1 = *(const f32x4*)(gn + c0 + 4);
    for (int m = gw; m < TT; m += NGW) {
        f32x4 v0 = *(const f32x4*)(OA + (size_t)m * 512 + c0), v1 = *(const f32x4*)(OA + (size_t)m * 512 + c0 + 4);
        const h8 gg = *(const h8*)(AG + (size_t)m * 512 + c0);
        float s = (v0[0] * v0[0] + v0[1] * v0[1]) + (v0[2] * v0[2] + v0[3] * v0[3]) + (v1[0] * v1[0] + v1[1] * v1[1]) + (v1[2] * v1[2] + v1[3] * v1[3]);
        s = red16(s);
        const float rstd = rsqrtf(s * (1.0f / 128.0f) + 1e-6f);
#pragma unroll
        for (int j = 0; j < 4; ++j) { v0[j] = v0[j] * rstd * g0[j] * (float)gg[j]; v1[j] = v1[j] * rstd * g1[j] * (float)gg[4 + j]; }
        st8_bf16(Y + (size_t)m * 1024 + c0, v0, v1);
    }
}

DI void knorm_phase(const Args& A, int lane, int wave) {
    u16* BK = (u16*)(A.ws + WS_PROJ) + 5 * PSTR; const float* gk = A.in[8];
    const int gw = blockIdx.x * 8 + wave, NGW = gridDim.x * 8, c0 = lane * 8;
    const f32x4 g0 = *(const f32x4*)(gk + (c0 & 63)), g1 = *(const f32x4*)(gk + (c0 & 63) + 4);
    for (int m = gw; m < TT; m += NGW) {
        const u32x4 w = *(const u32x4*)(BK + (size_t)m * 512 + c0);
        f32x4 v0, v1;
        v0[0] = __uint_as_float(w.x << 16); v0[1] = __uint_as_float(w.x & 0xffff0000u); v0[2] = __uint_as_float(w.y << 16); v0[3] = __uint_as_float(w.y & 0xffff0000u);
        v1[0] = __uint_as_float(w.z << 16); v1[1] = __uint_as_float(w.z & 0xffff0000u); v1[2] = __uint_as_float(w.w << 16); v1[3] = __uint_as_float(w.w & 0xffff0000u);
        float s = (v0[0] * v0[0] + v0[1] * v0[1]) + (v0[2] * v0[2] + v0[3] * v0[3]) + (v1[0] * v1[0] + v1[1] * v1[1]) + (v1[2] * v1[2] + v1[3] * v1[3]);
        s = red8(s);
        const float rstd = rsqrtf(s * (1.0f / 64.0f) + 1e-6f);
        v0 = v0 * rstd * g0; v1 = v1 * rstd * g1;
        st8_bf16(BK + (size_t)m * 512 + c0, v0, v1);
    }
}

DI void norm1_phase(const Args& A, int lane, int wave) {
    const u16* hsrc = (const u16*)A.out; const float* g = A.in[1] + 1024; const float* mu = A.in[10]; u16* XN = (u16*)(A.ws + WS_XN); u16* MX = (u16*)(A.ws + WS_PROJ);
    const int gw = blockIdx.x * 8 + wave, NGW = gridDim.x * 8;
    if (gw < NB) { u32x2* o8 = (u32x2*)(XN + (size_t)gw * 4097 * 1024) + lane;
#pragma unroll
        for (int j = 0; j < 4; ++j) o8[64 * j] = (u32x2){0u, 0u}; }
    f32x4 gv[4], mu0[4], mu2[4], mu3[4];
#pragma unroll
    for (int j = 0; j < 4; ++j) { const int c = 4 * lane + 256 * j; gv[j] = *(const f32x4*)(g + c); mu0[j] = *(const f32x4*)(mu + c); mu2[j] = *(const f32x4*)(mu + 2 * 1024 + c); mu3[j] = *(const f32x4*)(mu + 3 * 1024 + c); }
    asm volatile("" ::: "memory");
    const int rows_per = TT / NGW;
    const int m0 = gw * rows_per;
    f32x4 prev[4];
    if ((m0 & 4095) == 0) {
#pragma unroll
        for (int j = 0; j < 4; ++j) prev[j] = (f32x4){0.f, 0.f, 0.f, 0.f};
    } else {
        const u32x2* xr = (const u32x2*)(hsrc + (size_t)(m0 - 1) * 1024) + lane; float s = 0.f;
#pragma unroll
        for (int j = 0; j < 4; ++j) { const u32x2 w_ = xr[64 * j]; prev[j] = (f32x4){__uint_as_float(w_.x << 16), __uint_as_float(w_.x & 0xffff0000u), __uint_as_float(w_.y << 16), __uint_as_float(w_.y & 0xffff0000u)}; s += (prev[j][0] * prev[j][0] + prev[j][1] * prev[j][1]) + (prev[j][2] * prev[j][2] + prev[j][3] * prev[j][3]); }
        const float rstd = rsqrtf(wave_sum(s) * (1.0f / 1024.0f) + 1e-6f);
#pragma unroll
        for (int j = 0; j < 4; ++j) prev[j] = prev[j] * rstd * gv[j];
    }
    for (int m = m0; m < m0 + rows_per; ++m) {
        const u32x2* xr = (const u32x2*)(hsrc + (size_t)m * 1024) + lane;
        f32x4 v[4]; float s = 0.f;
#pragma unroll
        for (int j = 0; j < 4; ++j) { const u32x2 w_ = xr[64 * j]; v[j] = (f32x4){__uint_as_float(w_.x << 16), __uint_as_float(w_.x & 0xffff0000u), __uint_as_float(w_.y << 16), __uint_as_float(w_.y & 0xffff0000u)}; s += (v[j][0] * v[j][0] + v[j][1] * v[j][1]) + (v[j][2] * v[j][2] + v[j][3] * v[j][3]); }
        const float rstd = rsqrtf(wave_sum(s) * (1.0f / 1024.0f) + 1e-6f);
        if ((m & 4095) == 0) {
#pragma unroll
            for (int j = 0; j < 4; ++j) prev[j] = (f32x4){0.f, 0.f, 0.f, 0.f};
        }
        const size_t prow = (size_t)(m >> 12) * 4097 + 1 + (m & 4095);
        u32x2* o8 = (u32x2*)(XN + prow * 1024) + lane;
        u32x2* o0 = (u32x2*)(MX + (size_t)m * 1024) + lane; u32x2* o1 = (u32x2*)(MX + RSTR + (size_t)m * 1024) + lane; u32x2* o2 = (u32x2*)(MX + 2 * RSTR + (size_t)m * 1024) + lane;
#pragma unroll
        for (int j = 0; j < 4; ++j) {
            v[j] = v[j] * rstd * gv[j];
            const f32x4 xx = prev[j] - v[j];
            u32x2 w; w.x = pk_bf16(v[j][0], v[j][1]); w.y = pk_bf16(v[j][2], v[j][3]); o8[64 * j] = w;
            f32x4 t = v[j] + xx * mu0[j];            w.x = pk_bf16(t[0], t[1]); w.y = pk_bf16(t[2], t[3]); o0[64 * j] = w;
            t = v[j] + xx * mu2[j];       w.x = pk_bf16(t[0], t[1]); w.y = pk_bf16(t[2], t[3]); o1[64 * j] = w;
            t = v[j] + xx * mu3[j];       w.x = pk_bf16(t[0], t[1]); w.y = pk_bf16(t[2], t[3]); o2[64 * j] = w;
            prev[j] = v[j];
        }
    }
}

DI void wkv_phase(const Args& A, LAS unsigned char* lds, int tid, int lane, int wave) {
    typedef short bfx8 __attribute__((ext_vector_type(8)));
    const int blk = blockIdx.x; if (blk >= 256) return;
    const int b = blk >> 4, hh = blk & 15;
    const _Float16* R = (const _Float16*)(A.ws + WS_RKV); const _Float16* KR = R + RSTR; const _Float16* V = R + 2 * RSTR;
    const u16* LH = (const u16*)(A.ws + WS_LH); const u16* W2 = (const u16*)(A.ws + WS_W2);
    u16* Z = (u16*)(A.ws + WS_XN);
    constexpr int CH = 32;
    LAS float* Lw = (LAS float*)lds; LAS float* La = Lw + CH * 64; LAS float* Lb = La + CH * 64; LAS float* Lk = Lb + CH * 64; LAS float* Lr = Lk + CH * 64; LAS float* Lv = Lr + CH * 64;
    LAS float* Ly = Lv + CH * 64; LAS float* Lbon = Ly + CH * 256;
    LAS float* Lga = Lbon + 64; LAS float* Lgg = Lga + CH * 64;
    const int pt = tid >> 4, pi = (tid & 15) * 4;
    const int ch = hh * 64 + pi;
    const f32x4 c_kk = *(const f32x4*)(A.in[20] + ch), c_ka = *(const f32x4*)(A.in[21] + ch), c_rk = *(const f32x4*)(A.in[22] + ch), c_lg = *(const f32x4*)(A.in[23] + ch), c_lb = *(const f32x4*)(A.in[24] + ch);
    const int v0 = wave * 8 + (lane >> 4) * 2, k0 = (lane & 15) * 4;
    const size_t row0 = (size_t)b * SQ;
    const int l16 = lane & 15, lq = lane >> 4, ct = wave >> 1, tt = wave & 1;
    bfx8 xw[2], xa[2], xg[4];
    { const u16* wp = W2 + (size_t)(hh * 64 + 16 * ct + l16) * 128 + 8 * lq;
#pragma unroll
      for (int kk = 0; kk < 2; ++kk) { xw[kk] = *(const bfx8*)(wp + 32 * kk); xa[kk] = *(const bfx8*)(wp + (size_t)1024 * 128 + 32 * kk); }
#pragma unroll
      for (int kk = 0; kk < 4; ++kk) xg[kk] = *(const bfx8*)(wp + (size_t)2048 * 128 + 32 * kk); }
    const int mch = 16 * ct + l16;
    const float bw0 = A.in[12][hh * 64 + mch], ba0 = A.in[15][hh * 64 + mch];
    f32x2 S0a = {0.f, 0.f}, S0b = {0.f, 0.f}, S1a = {0.f, 0.f}, S1b = {0.f, 0.f};
    h4 xr, xk, xv; f32x4 g_cur; bfx8 yl[8];
#define WK_LOAD(c) do { const size_t g = (row0 + (size_t)(c) * CH + pt) * 1024 + ch; xr = *(const h4*)(R + g); xk = *(const h4*)(KR + g); xv = *(const h4*)(V + g); \
        const u16* lp_ = LH + (row0 + (size_t)(c) * CH + 16 * tt + l16) * 256 + 8 * lq; \
        _Pragma("unroll") for (int kk = 0; kk < 2; ++kk) { yl[kk] = *(const bfx8*)(lp_ + 32 * kk); yl[2 + kk] = *(const bfx8*)(lp_ + 64 + 32 * kk); } \
        _Pragma("unroll") for (int kk = 0; kk < 4; ++kk) yl[4 + kk] = *(const bfx8*)(lp_ + 128 + 32 * kk); } while (0)
#define WK_LORA() do { f32x4 dw = {0.f, 0.f, 0.f, 0.f}, da = {0.f, 0.f, 0.f, 0.f}, dg = {0.f, 0.f, 0.f, 0.f}; \
        _Pragma("unroll") for (int kk = 0; kk < 2; ++kk) { dw = __builtin_amdgcn_mfma_f32_16x16x32_bf16(yl[kk], xw[kk], dw, 0, 0, 0); da = __builtin_amdgcn_mfma_f32_16x16x32_bf16(yl[2 + kk], xa[kk], da, 0, 0, 0); } \
        _Pragma("unroll") for (int kk = 0; kk < 4; ++kk) dg = __builtin_amdgcn_mfma_f32_16x16x32_bf16(yl[4 + kk], xg[kk], dg, 0, 0, 0); \
        _Pragma("unroll") for (int j = 0; j < 4; ++j) { dw[j] = __expf(-0.60653066f * sigm(dw[j] + bw0)); da[j] = sigm(da[j] + ba0); \
            const int o_ = (16 * tt + 4 * lq + j) * 64 + mch; Lw[o_] = dw[j]; Lga[o_] = da[j]; Lgg[o_] = dg[j]; } } while (0)
    WK_LOAD(0);
    WK_LORA();
    constexpr int NCH = SQ / CH;
    for (int c = 0; c < NCH; ++c) {
        __syncthreads();
        {
            f32x4 r4, k4, v4, kk, kx, an, bn;
            const f32x4 a4 = *(const LAS f32x4*)(Lga + pt * 64 + pi); g_cur = *(const LAS f32x4*)(Lgg + pt * 64 + pi);
#pragma unroll
            for (int j = 0; j < 4; ++j) { r4[j] = (float)xr[j]; k4[j] = (float)xk[j]; v4[j] = (float)xv[j]; }
            kk = k4 * c_kk;
            float ssq = (kk[0] * kk[0] + kk[1] * kk[1]) + (kk[2] * kk[2] + kk[3] * kk[3]); ssq = red16(ssq);
            const float inv = rsqrtf(fmaxf(ssq, 1e-24f));
            float bon = 0.f;
#pragma unroll
            for (int j = 0; j < 4; ++j) { const float kn = kk[j] * inv; kx[j] = k4[j] * (1.0f + (a4[j] - 1.0f) * c_ka[j]); an[j] = -kn; bn[j] = kn * a4[j]; bon += r4[j] * kx[j] * c_rk[j]; }
            bon = red16(bon);
            const int o = pt * 64 + pi;
            *(LAS f32x4*)(La + o) = an; *(LAS f32x4*)(Lb + o) = bn; *(LAS f32x4*)(Lk + o) = kx; *(LAS f32x4*)(Lr + o) = r4; *(LAS f32x4*)(Lv + o) = v4;
            if ((tid & 15) == 0) Lbon[pt] = bon;
        }
        __syncthreads();
        if (c + 1 < NCH) WK_LOAD(c + 1);
        f32x4 na4 = *(const LAS f32x4*)(La + k0), nw4 = *(const LAS f32x4*)(Lw + k0), nb4 = *(const LAS f32x4*)(Lb + k0), nk4 = *(const LAS f32x4*)(Lk + k0), nr4 = *(const LAS f32x4*)(Lr + k0);
        f32x2 nvv = *(const LAS f32x2*)(Lv + v0);
#pragma unroll 4
        for (int t = 0; t < CH; ++t) {
            const f32x4 a4 = na4, w4 = nw4, b4 = nb4, k4 = nk4, r4 = nr4; const f32x2 vv = nvv;
            { const int o = (t + 1) * 64 + k0;
              na4 = *(const LAS f32x4*)(La + o); nw4 = *(const LAS f32x4*)(Lw + o); nb4 = *(const LAS f32x4*)(Lb + o); nk4 = *(const LAS f32x4*)(Lk + o); nr4 = *(const LAS f32x4*)(Lr + o);
              nvv = *(const LAS f32x2*)(Lv + (t + 1) * 64 + v0); }
            const f32x2 alo = {a4[0], a4[1]}, ahi = {a4[2], a4[3]}, wlo = {w4[0], w4[1]}, whi = {w4[2], w4[3]}, blo = {b4[0], b4[1]}, bhi = {b4[2], b4[3]}, klo = {k4[0], k4[1]}, khi = {k4[2], k4[3]}, rlo = {r4[0], r4[1]}, rhi = {r4[2], r4[3]};
            f32x2 p0 = S0a * alo + S0b * ahi, p1 = S1a * alo + S1b * ahi;
            const float sa0 = red16(p0.x + p0.y), sa1 = red16(p1.x + p1.y);
            const f32x2 sa0v = {sa0, sa0}, sa1v = {sa1, sa1}, v0v = {vv.x, vv.x}, v1v = {vv.y, vv.y};
            S0a = S0a * wlo + (sa0v * blo + v0v * klo); S0b = S0b * whi + (sa0v * bhi + v0v * khi);
            S1a = S1a * wlo + (sa1v * blo + v1v * klo); S1b = S1b * whi + (sa1v * bhi + v1v * khi);
            p0 = S0a * rlo + S0b * rhi; p1 = S1a * rlo + S1b * rhi;
            float y0 = p0.x + p0.y, y1 = p1.x + p1.y;
            y0 += dpp_f<0xB1>(y0); y1 += dpp_f<0xB1>(y1); y0 += dpp_f<0x4E>(y0); y1 += dpp_f<0x4E>(y1);
            if ((lane & 3) == 0) *(LAS f32x2*)(Ly + t * 256 + ((lane & 15) >> 2) * 64 + v0) = (f32x2){y0, y1};
        }
        __syncthreads();
        {
            const int o = pt * 64 + pi;
            const f32x4 y4 = (*(const LAS f32x4*)(Ly + pt * 256 + pi) + *(const LAS f32x4*)(Ly + pt * 256 + 64 + pi)) + (*(const LAS f32x4*)(Ly + pt * 256 + 128 + pi) + *(const LAS f32x4*)(Ly + pt * 256 + 192 + pi)), v4 = *(const LAS f32x4*)(Lv + o); const float bon = Lbon[pt];
            const float mean = red16((y4[0] + y4[1]) + (y4[2] + y4[3])) * (1.0f / 64.0f);
            const f32x4 d = y4 - mean;
            const float var = red16((d[0] * d[0] + d[1] * d[1]) + (d[2] * d[2] + d[3] * d[3])) * (1.0f / 64.0f);
            const float rs = rsqrtf(var + 64e-5f);
            float z[4];
#pragma unroll
            for (int j = 0; j < 4; ++j) z[j] = (d[j] * rs * c_lg[j] + c_lb[j] + bon * v4[j]) * g_cur[j];
            u32x2 w; w.x = pk_bf16(z[0], z[1]); w.y = pk_bf16(z[2], z[3]);
            *(u32x2*)(Z + (row0 + (size_t)c * CH + pt) * 1024 + ch) = w;
        }
        if (c + 1 < NCH) WK_LORA();
    }
#undef WK_LOAD
#undef WK_LORA
}

#define XB_TMO      128
#define XB_XCNT(j)  (256  + 64 * (j))
#define XB_XSUB(j)  (1280 + 64 * (j))
#define XB_XGEN(j)  (2304 + 64 * (j))
#define XB_TOP      3328
#define XB_TOPGEN   3392
#define XCD_BAR_WORDS 3456
#define XB_SPIN_CAP (1u << 18)

__device__ __forceinline__ unsigned xb_ld(unsigned* p)              { return __hip_atomic_load(p, __ATOMIC_RELAXED, __HIP_MEMORY_SCOPE_AGENT); }
__device__ __forceinline__ unsigned xb_add(unsigned* p, unsigned v) { return __hip_atomic_fetch_add(p, v, __ATOMIC_RELAXED, __HIP_MEMORY_SCOPE_AGENT); }
__device__ __forceinline__ unsigned xb_xcc_id() { return (unsigned)__builtin_amdgcn_s_getreg((3 << 11) | 20) & 0xFu; }
#define XB_SPIN(cond, bar) do { unsigned _sp = 0; while (cond) { __builtin_amdgcn_s_sleep(1); \
    if ((++_sp & 255u) == 0u) { if (xb_ld(&(bar)[XB_TMO])) break; if (_sp > XB_SPIN_CAP) { atomicAdd(&(bar)[XB_TMO], 1u); break; } } } } while (0)

struct XcdBarrier {
    unsigned* bar; unsigned x;
    volatile LAS unsigned* st;
};

__device__ __forceinline__ XcdBarrier xcd_barrier_post(unsigned* bar, volatile LAS unsigned* st) {
    XcdBarrier b; b.bar = bar; b.x = xb_xcc_id(); b.st = st;
    if (threadIdx.x == 0) (void)xb_add(&bar[XB_XCNT(b.x)], 1u);
    return b;
}
__device__ __forceinline__ void xcd_barrier_complete(unsigned* bar, unsigned x, unsigned& nloc, unsigned& nx) {
    const unsigned G = gridDim.x * gridDim.y * gridDim.z;
    unsigned sum, cnt, mine, sp = 0u;
    for (;;) {
        sum = 0u; cnt = 0u; mine = 0u;
#pragma unroll
        for (unsigned j = 0; j < 16; ++j) { const unsigned c = xb_ld(&bar[XB_XCNT(j)]); sum += c; cnt += (c > 0u) ? 1u : 0u; mine = (j == x) ? c : mine; }
        if (sum == G) break;
        __builtin_amdgcn_s_sleep(1);
        if ((++sp & 255u) == 0u) { if (xb_ld(&bar[XB_TMO])) break; if (sp > XB_SPIN_CAP) { atomicAdd(&bar[XB_TMO], 1u); break; } }
    }
    nloc = mine > 0u ? mine : 1u; nx = cnt > 0u ? cnt : 1u;
}

__device__ __forceinline__ void xcd_barrier(const XcdBarrier& b) {
    asm volatile("s_waitcnt vmcnt(0)" ::: "memory");
    __syncthreads();
    if (threadIdx.x == 0) {
        unsigned* bar = b.bar;
        __builtin_amdgcn_s_waitcnt(0);
        unsigned nloc = b.st[0], nx = b.st[1];
        if (nloc == 0u) { xcd_barrier_complete(bar, b.x, nloc, nx); b.st[0] = nloc; b.st[1] = nx; }
        const unsigned old = xb_add(&bar[XB_XSUB(b.x)], 1u);
        const unsigned gen = old / nloc;
        if (old + 1u == (gen + 1u) * nloc) {
            __builtin_amdgcn_fence(__ATOMIC_RELEASE, "agent");
            asm volatile("s_waitcnt vmcnt(0)" ::: "memory");
            const unsigned og = xb_add(&bar[XB_TOP], 1u);
            const unsigned tg = og / nx;
            if (og + 1u == (tg + 1u) * nx) xb_add(&bar[XB_TOPGEN], 1u);
            else XB_SPIN(xb_ld(&bar[XB_TOPGEN]) == tg, bar);
            __builtin_amdgcn_fence(__ATOMIC_ACQUIRE, "agent");
            xb_add(&bar[XB_XGEN(b.x)], 1u);
            asm volatile("s_waitcnt vmcnt(0)" ::: "memory");
        } else {
            XB_SPIN(xb_ld(&bar[XB_XGEN(b.x)]) == gen, bar);
            __builtin_amdgcn_fence(__ATOMIC_ACQUIRE, "agent");
            asm volatile("s_waitcnt vmcnt(0)" ::: "memory");
        }
    }
    __syncthreads();
}

struct RstdOrder : pg8::StaticOrder {
    const float* SS; LAS float* rs; mutable int k;
    DI void a_ready(const pg8::Unit& u) const {
        const int tid = threadIdx.x;
        if (tid < 256) { const float* p = SS + (size_t)(u.pm * 256 + tid) * 16;
            const f32x4 q0 = *(const f32x4*)p, q1 = *(const f32x4*)(p + 4), q2 = *(const f32x4*)(p + 8), q3 = *(const f32x4*)(p + 12); const f32x4 qs = (q0 + q1) + (q2 + q3);
            rs[(k & 1) * 256 + tid] = rsqrtf(((qs[0] + qs[1]) + (qs[2] + qs[3])) * (1.0f / 1024.0f) + 1e-6f); }
        ++k;
    }
};
DI void run_gemm_up(LAS unsigned char* lds, const pg8::bf16_t* Amat, const pg8::bf16_t* Bt, const float* SS, u16* HID) {
    pg8::Gemm g{Amat, Bt, TT, 4096, 1024, 1024, 0}; RstdOrder S; S.init(TT, 4096, (int)gridDim.x, (int)blockIdx.x); S.SS = SS; S.rs = (LAS float*)(lds + 131072); S.k = 0;
    Epi<2> E{EpiArgs{HID, nullptr, nullptr, nullptr, nullptr, nullptr}}; E.rs = (const LAS float*)(lds + 131072); E.ucnt = 0;
    pg8::gemm_phase<Epi<2>, RstdOrder, true, true>(lds, g, S, E);
}
template <int MODE> DI void run_gemm(LAS unsigned char* lds, const pg8::bf16_t* Amat, const pg8::bf16_t* Bt, int N, int K, int lda, int amode, const EpiArgs& ea, int rev = 0) {
    pg8::Gemm g{Amat, Bt, TT, N, K, lda, amode}; pg8::StaticOrder S; S.init(TT, N, (int)gridDim.x, (int)blockIdx.x); S.rev = rev;
    Epi<MODE> E{ea}; E.rs = (const LAS float*)(lds + 133120);
    pg8::gemm_phase<Epi<MODE>, pg8::StaticOrder, true, true>(lds, g, S, E);
}

__global__ void __launch_bounds__(512, 2) mega_fwd(Args A) {
    extern __shared__ __attribute__((aligned(16))) unsigned char lds_raw[];
    LAS unsigned char* lds = (LAS unsigned char*)lds_raw;
    cg::grid_group grid = cg::this_grid();
    unsigned char* ws = A.ws;
    volatile LAS unsigned* bst = (volatile LAS unsigned*)(lds + LDS_TOTAL - 64);
    if (threadIdx.x < 2) bst[threadIdx.x] = 0u;
    __syncthreads();
    const XcdBarrier xbar = xcd_barrier_post((unsigned*)(ws + WS_BAR), bst);
#define GSYNC() xcd_barrier(xbar)
#define TIDS int tid = threadIdx.x; asm volatile("" : "+v"(tid) :: "memory"); const int lane = tid & 63, wave = __builtin_amdgcn_readfirstlane(tid >> 6); (void)lane; (void)wave;
    typedef pg8::bf16_t bt;
    { TIDS p0_prologue(A, lds, tid, lane, wave); }
    GSYNC();
    if (A.ws == nullptr) grid.sync();
    { TIDS if (blockIdx.x < 128) fox_cumsum(A, lds, (int)blockIdx.x, tid, lane, wave); }
    { EpiArgs ea{(u16*)(ws + WS_PROJ), nullptr, (const float*)(ws + WS_LB), A.in[8], nullptr, (float*)(ws + WS_SSK)};
      run_gemm<0>(lds, (const bt*)(ws + WS_XN), (const bt*)(ws + WS_WIN), 4096, 1024, 1024, 0, ea); }
    GSYNC();
    {
        const attn_body::bf16* PB = (const attn_body::bf16*)(ws + WS_PROJ);
        const attn_body::AttnTensors AT{PB + 4 * PSTR, PB + 5 * PSTR, PB + 6 * PSTR, (attn_body::bf16*)(ws + WS_XN) + 512, (const float*)(ws + WS_SSK), (const float*)(ws + WS_CB), A.in[7], A.in[8], (const _Float16*)(ws + WS_PROJ) + 7 * PSTR};
        const attn_body::StaticOrder S((int)gridDim.x, (int)blockIdx.x);
        if (blockIdx.x < 128) { TIDS hgrn_mfma_phase(A, lds, tid, lane, wave); }
        __syncthreads();
        attn_body::attn_phase<attn_body::StaticOrder>((char*)lds_raw, AT, S);
    }
    GSYNC();
    { EpiArgs ea{(u16*)(ws + WS_HB), nullptr, A.in[0], nullptr, nullptr, (float*)(ws + WS_SS)};
      run_gemm<1>(lds, (const bt*)(ws + WS_XN), (const bt*)(ws + WS_WOUT), 1024, 1024, 1024, 0, ea); }
    GSYNC();
    run_gemm_up(lds, (const bt*)(ws + WS_HB), (const bt*)(ws + WS_WUP0), (const float*)(ws + WS_SS), (u16*)(ws + WS_PROJ));
    GSYNC();
    { EpiArgs ea{(u16*)A.out, (u16*)(ws + WS_HB), nullptr, nullptr, nullptr, nullptr};
      run_gemm<1>(lds, (const bt*)(ws + WS_PROJ), (const bt*)(ws + WS_WD0), 1024, 4096, 4096, 0, ea, 1); }
    GSYNC();
    { TIDS norm1_phase(A, lane, wave); }
    GSYNC();
    { EpiArgs ea{(u16*)(ws + WS_RKV), (u16*)(ws + WS_LH), nullptr, nullptr, nullptr, nullptr};
      run_gemm<3>(lds, (const bt*)(ws + WS_PROJ), (const bt*)(ws + WS_WBIG), 3072, 1024, 1024, 3, ea);
      run_gemm<5>(lds, (const bt*)(ws + WS_XN), (const bt*)(ws + WS_WLORA), 256, 2048, 1024, 1, ea); }
    GSYNC();
    { TIDS wkv_phase(A, lds, tid, lane, wave); }
    GSYNC();
    { EpiArgs ea{(u16*)(ws + WS_HB), (u16*)A.out, nullptr, nullptr, nullptr, (float*)(ws + WS_SS)};
      run_gemm<1>(lds, (const bt*)(ws + WS_XN), (const bt*)(ws + WS_WO), 1024, 1024, 1024, 0, ea); }
    GSYNC();
    run_gemm_up(lds, (const bt*)(ws + WS_HB), (const bt*)(ws + WS_WUP1), (const float*)(ws + WS_SS), (u16*)(ws + WS_PROJ));
    GSYNC();
    { EpiArgs ea{nullptr, (u16*)(ws + WS_HB), nullptr, nullptr, A.out, nullptr};
      run_gemm<1>(lds, (const bt*)(ws + WS_PROJ), (const bt*)(ws + WS_WD1), 1024, 4096, 4096, 0, ea, 1); }
}

extern "C" void kernel_launch(void* const* d_in, const int* in_sizes, int n_in, void* d_out, int out_size, void* d_ws, size_t ws_size, hipStream_t stream) {
    static int ready = 0;
    if (!ready) {
        if (n_in != 28 || ws_size < WS_END) { fprintf(stderr, "kernel_launch: unexpected n_in %d / ws_size %zu\n", n_in, ws_size); ready = -1; return; }
        if (hipFuncSetAttribute((const void*)mega_fwd, hipFuncAttributeMaxDynamicSharedMemorySize, LDS_TOTAL) != hipSuccess) { fprintf(stderr, "kernel_launch: hipFuncSetAttribute failed\n"); ready = -1; return; }
        int per_cu = 0; (void)hipOccupancyMaxActiveBlocksPerMultiprocessor(&per_cu, (const void*)mega_fwd, 512, LDS_TOTAL); (void)hipGetLastError();
        if (per_cu < 1) fprintf(stderr, "kernel_launch: occupancy query says %d blocks/CU\n", per_cu);
        ready = 1;
    }
    if (ready < 0) return;
    if (hipMemsetAsync((char*)d_ws + WS_BAR, 0, BAR_BYTES, stream) != hipSuccess) { fprintf(stderr, "kernel_launch: memset failed\n"); return; }
    Args a{};
    for (int i = 0; i < 28; ++i) a.in[i] = (const float*)d_in[i];
    a.out = (float*)d_out; a.ws = (unsigned char*)d_ws;
    void* args[] = {&a};
    hipError_t e = hipLaunchCooperativeKernel((const void*)mega_fwd, dim3(256), dim3(512), args, LDS_TOTAL, stream);
    if (e != hipSuccess) fprintf(stderr, "cooperative launch failed: %s\n", hipGetErrorString(e));
}
```

```cpp
#include <hip/hip_runtime.h>
#include <hip/hip_cooperative_groups.h>
#include <hip/hip_bf16.h>
#include <cstdio>
#include <cstdint>
#include <cmath>
namespace cg = cooperative_groups;

namespace pg8 {
#define PG8_LAS __attribute__((address_space(3)))
typedef unsigned short bf16_t;
typedef short bf16x8 __attribute__((ext_vector_type(8)));
typedef float f32x4 __attribute__((ext_vector_type(4)));
typedef unsigned u32x4 __attribute__((ext_vector_type(4)));
constexpr int BM = 256, BK = 64, HALF = 128, HTB = HALF * BK * 2  , STAGE_BYTES = 8 * HTB, NXCD = 8, WGM = 8;

__host__ __device__ __forceinline__ int lds_byte(int r, int c) { const int st = (r >> 4) * 2 + (c >> 5), rr = r & 15, cc = c & 31, ob = rr * 64 + cc * 2; return st * 1024 + (ob ^ (((ob >> 9) & 1) << 5)); }
__host__ __device__ __forceinline__ void stage_rc(int b, int& R, int& C) { const int st = b / 1024, sb = b % 1024, swz = sb ^ (((sb >> 9) & 1) << 5); R = (st >> 1) * 16 + swz / 64; C = (st & 1) * 32 + (swz % 64) / 2; }
__host__ __device__ __forceinline__ int perm32(int rho) { const int n = rho >> 4, i = rho & 15; return 8 * (i >> 2) + 4 * n + (i & 3); }

struct Unit { int pm, pn; };
struct Gemm { const bf16_t* A; const bf16_t* Bt; int M, N, K, lda, amode; };
__device__ __forceinline__ const char* a_base(const Gemm& g, const Unit& u) {
    if (g.amode == 1) return (const char*)g.A + (size_t)((u.pm >> 4) * 4097 + 1 + (u.pm & 15) * 256) * g.lda * 2;
    if (g.amode == 3) return (const char*)g.A + (size_t)(u.pn >> 2) * ((size_t)65536 * 1024 * 2) + (size_t)u.pm * 256 * g.lda * 2;
    if (g.amode == 2) return (const char*)g.A + (size_t)u.pm * 256 * g.lda * 2 + (size_t)(u.pn >> 2) * 128;
    return (const char*)g.A + (size_t)u.pm * 256 * g.lda * 2;
}
struct StaticOrder {
    int nM, nN, nwg, G, c, rev = 0;
    __host__ __device__ void init(int M, int N, int G_, int c_) { nM = M / BM; nN = N / BM; nwg = nM * nN; G = G_; c = c_; }
    __host__ __device__ bool next(int i, Unit& u) const {
        const long L = (long)i * G + c; if (L >= nwg) return false;
        int wgid = (int)L; { const int q = nwg / NXCD, r = nwg % NXCD, xcd = wgid % NXCD, off = wgid / NXCD; wgid = (xcd < r ? xcd * (q + 1) : r * (q + 1) + (xcd - r) * q) + off; }
        const int nig = WGM * nN, gid = wgid / nig, fm = gid * WGM, gsz = (nM - fm) < WGM ? (nM - fm) : WGM;
        u.pm = fm + ((wgid % nig) % gsz); u.pn = (wgid % nig) / gsz; if (rev) u.pm = nM - 1 - u.pm; return true;
    }
    __device__ __forceinline__ void a_ready(const Unit&) const {}
    __device__ __forceinline__ void done(const Unit&) const {}
};
template <class Epi, class Sched, bool ALIGN_EPI = false, bool SP2 = false>
__device__ __forceinline__ void gemm_phase(PG8_LAS unsigned char* lds, const Gemm g, const Sched& S, const Epi& E) {
    int tid = threadIdx.x; asm volatile("" : "+v"(tid) :: "memory"); const int wid = __builtin_amdgcn_readfirstlane(tid >> 6), lane = tid & 63, wr = wid >> 2, wc = wid & 3, fr = lane & 15, fq = lane >> 4;
    const int K = g.K, nt = K / BK;
    unsigned voffA[2], voffB[2];
#pragma unroll
    for (int i = 0; i < 2; ++i) { int R, C; stage_rc(tid * 16 + i * 8192, R, C); const int Rb = Epi::PERM ? ((R & ~31) + perm32(R & 31)) : R;
        voffA[i] = (unsigned)(R * g.lda + C) * 2u; voffB[i] = (unsigned)(Rb * K + C) * 2u; }
    const size_t kstep = (size_t)(BK * 2);
    const size_t hstepB = (size_t)HALF * K * 2, hstepA = (size_t)HALF * g.lda * 2;
    const size_t tstepB = 2 * hstepB; const int shT = (g.amode == 1) ? 16 : (1 << 30); const size_t shB = (size_t)(g.lda + 1024) * 2;
    const unsigned ldsw = (unsigned)wid * 1024u;
    const int aoff = lds_byte(wr * 64 + fr, fq * 8), boff = lds_byte(wc * 32 + fr, fq * 8);
#define PG8_SA(b, h) (((b) * 2 + (h)) * HTB)
#define PG8_SB(b, h) ((4 + (b) * 2 + (h)) * HTB)
#define PG8_STAGE(bufoff, gbase, voff) do { _Pragma("unroll") for (int _i = 0; _i < 2; ++_i) \
        __builtin_amdgcn_global_load_lds((const unsigned*)((const char*)(gbase) + (voff)[_i]), (PG8_LAS unsigned*)(lds + (bufoff) + ldsw + _i * 8192), 16, 0, 0); } while (0)
#define PG8_LDA(dst, b, h) do { _Pragma("unroll") for (int m = 0; m < 4; ++m) _Pragma("unroll") for (int k = 0; k < 2; ++k) dst[m][k] = *(const PG8_LAS bf16x8*)(lds + PG8_SA(b, h) + aoff + m * 2048 + k * 1024); } while (0)
#define PG8_LDB(dst, b, h) do { _Pragma("unroll") for (int n = 0; n < 2; ++n) _Pragma("unroll") for (int k = 0; k < 2; ++k) dst[n][k] = *(const PG8_LAS bf16x8*)(lds + PG8_SB(b, h) + boff + n * 2048 + k * 1024); } while (0)
#define PG8_MMA(ai, bj, At, Bt) do { __builtin_amdgcn_s_setprio(1); _Pragma("unroll") for (int m = 0; m < 4; ++m) _Pragma("unroll") for (int n = 0; n < 2; ++n) _Pragma("unroll") for (int k = 0; k < 2; ++k) \
        acc[ai][bj][m][n] = __builtin_amdgcn_mfma_f32_16x16x32_bf16(Bt[n][k], At[m][k], acc[ai][bj][m][n], 0, 0, 0); __builtin_amdgcn_s_setprio(0); } while (0)
#define PG8_WAIT_V(n) asm volatile("s_waitcnt vmcnt(" #n ")" ::: "memory")
#define PG8_WAIT_L(n) asm volatile("s_waitcnt lgkmcnt(" #n ")" ::: "memory")
#define PG8_BAR __builtin_amdgcn_s_barrier()
#define PG8_SCHED __builtin_amdgcn_sched_barrier(0)
    Unit cur, nxt; int ui = 0;
    if (!S.next(0, cur)) return;
    f32x4 acc[2][2][4][2];
#pragma unroll
    for (int a = 0; a < 2; ++a)
#pragma unroll
        for (int b = 0; b < 2; ++b)
#pragma unroll
            for (int m = 0; m < 4; ++m)
#pragma unroll
                for (int n = 0; n < 2; ++n) acc[a][b][m][n] = (f32x4){0.f, 0.f, 0.f, 0.f};
    bf16x8 At[4][2], B0[2][2], B1[2][2];
    const char* cA = a_base(g, cur); const char* cB = (const char*)g.Bt + (size_t)cur.pn * tstepB;
    S.a_ready(cur);
    if constexpr (SP2) {
        PG8_STAGE(PG8_SB(0, 0), cB, voffB); PG8_STAGE(PG8_SB(0, 1), cB + hstepB, voffB); PG8_STAGE(PG8_SA(0, 0), cA, voffA); PG8_STAGE(PG8_SA(0, 1), cA + hstepA, voffA);
        if (wr == 1) PG8_BAR;
        PG8_WAIT_V(2); PG8_BAR;
        PG8_STAGE(PG8_SB(1, 0), cB + kstep, voffB); PG8_STAGE(PG8_SA(1, 0), cA + kstep, voffA); PG8_STAGE(PG8_SB(1, 1), cB + hstepB + kstep, voffB);
        PG8_WAIT_V(6); PG8_BAR;
    } else {
        PG8_STAGE(PG8_SB(0, 0), cB, voffB); PG8_STAGE(PG8_SA(0, 0), cA, voffA); PG8_STAGE(PG8_SB(0, 1), cB + hstepB, voffB); PG8_STAGE(PG8_SA(0, 1), cA + hstepA, voffA);
        if (wr == 1) PG8_BAR;
        PG8_WAIT_V(4); PG8_BAR;
        PG8_STAGE(PG8_SB(1, 0), cB + kstep, voffB); PG8_STAGE(PG8_SA(1, 0), cA + kstep, voffA); PG8_STAGE(PG8_SB(1, 1), cB + hstepB + kstep, voffB);
        PG8_WAIT_V(6); PG8_BAR;
    }
    for (;;) {
        const bool has_next = S.next(ui + 1, nxt);
        const char* nA = has_next ? a_base(g, nxt) : cA; const char* nB = has_next ? (const char*)g.Bt + (size_t)nxt.pn * tstepB : cB;
        for (int t = 0; t < nt; t += 2) {
            const bool last = (t == nt - 2);
            const char* a1 = cA + (size_t)(t + 1) * kstep - ((t + 1) >= shT ? shB : 0);
            const char* a2 = last ? nA : cA + (size_t)(t + 2) * kstep - ((t + 2) >= shT ? shB : 0); const char* b2 = last ? nB : cB + (size_t)(t + 2) * kstep;
            const char* a3 = last ? nA + kstep : cA + (size_t)(t + 3) * kstep - ((t + 3) >= shT ? shB : 0); const char* b3 = b2 + kstep;
            if (last && has_next) S.a_ready(nxt);
            if constexpr (SP2) {
            PG8_LDB(B0, 0, 0); PG8_LDB(B1, 0, 1); PG8_SCHED; PG8_LDA(At, 0, 0); PG8_STAGE(PG8_SA(1, 1), a1 + hstepA, voffA);
            PG8_WAIT_V(8); PG8_WAIT_L(0); PG8_BAR; PG8_MMA(0, 0, At, B0); PG8_MMA(0, 1, At, B1); PG8_BAR; PG8_SCHED;
            PG8_LDA(At, 0, 1); PG8_STAGE(PG8_SB(0, 0), b2, voffB); PG8_STAGE(PG8_SB(0, 1), b2 + hstepB, voffB); PG8_STAGE(PG8_SA(0, 0), a2, voffA);
            PG8_WAIT_V(8); PG8_WAIT_L(0); PG8_BAR; PG8_MMA(1, 0, At, B0); PG8_MMA(1, 1, At, B1); PG8_BAR; PG8_SCHED;
            PG8_LDB(B0, 1, 0); PG8_LDB(B1, 1, 1); PG8_SCHED; PG8_LDA(At, 1, 0); PG8_STAGE(PG8_SA(0, 1), a2 + hstepA, voffA);
            PG8_WAIT_V(8); PG8_WAIT_L(0); PG8_BAR; PG8_MMA(0, 0, At, B0); PG8_MMA(0, 1, At, B1); PG8_BAR; PG8_SCHED;
            PG8_LDA(At, 1, 1); PG8_STAGE(PG8_SB(1, 0), b3, voffB); PG8_STAGE(PG8_SB(1, 1), b3 + hstepB, voffB); PG8_STAGE(PG8_SA(1, 0), a3, voffA);
            PG8_WAIT_V(8); PG8_WAIT_L(0); PG8_BAR; PG8_MMA(1, 0, At, B0); PG8_MMA(1, 1, At, B1); PG8_BAR; PG8_SCHED;
            } else {
            PG8_LDB(B0, 0, 0); PG8_SCHED; PG8_LDA(At, 0, 0); PG8_STAGE(PG8_SA(1, 1), a1 + hstepA, voffA);
            PG8_WAIT_L(8); PG8_BAR; PG8_WAIT_L(0); PG8_MMA(0, 0, At, B0); PG8_BAR; PG8_SCHED;
            PG8_LDB(B1, 0, 1); PG8_STAGE(PG8_SB(0, 0), b2, voffB);
            PG8_BAR; PG8_WAIT_L(0); PG8_MMA(0, 1, At, B1); PG8_BAR;
            PG8_LDA(At, 0, 1); PG8_STAGE(PG8_SA(0, 0), a2, voffA);
            PG8_BAR; PG8_WAIT_L(0); PG8_MMA(1, 0, At, B0); PG8_BAR; PG8_SCHED;
            PG8_STAGE(PG8_SB(0, 1), b2 + hstepB, voffB);
            PG8_WAIT_V(6); PG8_BAR; PG8_MMA(1, 1, At, B1); PG8_BAR;
            PG8_LDB(B0, 1, 0); PG8_SCHED; PG8_LDA(At, 1, 0); PG8_STAGE(PG8_SA(0, 1), a2 + hstepA, voffA);
            PG8_WAIT_L(8); PG8_BAR; PG8_WAIT_L(0); PG8_MMA(0, 0, At, B0); PG8_BAR; PG8_SCHED;
            PG8_LDB(B1, 1, 1); PG8_STAGE(PG8_SB(1, 0), b3, voffB);
            PG8_BAR; PG8_WAIT_L(0); PG8_MMA(0, 1, At, B1); PG8_BAR;
            PG8_LDA(At, 1, 1); PG8_STAGE(PG8_SA(1, 0), a3, voffA);
            PG8_BAR; PG8_WAIT_L(0); PG8_MMA(1, 0, At, B0); PG8_BAR; PG8_SCHED;
            PG8_STAGE(PG8_SB(1, 1), b3 + hstepB, voffB);
            PG8_WAIT_V(6); PG8_BAR; PG8_MMA(1, 1, At, B1); PG8_BAR;
            }
        }
        if constexpr (ALIGN_EPI) { if (wr == 0) PG8_BAR; }
        if constexpr (!Epi::AFTER_DRAIN) { E(acc, cur, wr, wc, fr, fq); S.done(cur); }
        if (!has_next) break;
#pragma unroll
        for (int a = 0; a < 2; ++a)
#pragma unroll
            for (int b = 0; b < 2; ++b)
#pragma unroll
                for (int m = 0; m < 4; ++m)
#pragma unroll
                    for (int n = 0; n < 2; ++n) acc[a][b][m][n] = (f32x4){0.f, 0.f, 0.f, 0.f};
        cur = nxt; cA = nA; cB = nB; ++ui;
        if constexpr (ALIGN_EPI) { if (wr == 1) PG8_BAR; }
    }
    PG8_WAIT_V(0);
    if constexpr (!ALIGN_EPI) { if (wr == 0) PG8_BAR; }
    PG8_BAR;
    if constexpr (Epi::AFTER_DRAIN) { E.fused(acc, cur, wr, wc, fr, fq, lds, wid, lane); S.done(cur); }
#undef PG8_SA
#undef PG8_SB
#undef PG8_STAGE
#undef PG8_LDA
#undef PG8_LDB
#undef PG8_MMA
#undef PG8_WAIT_V
#undef PG8_WAIT_L
#undef PG8_BAR
#undef PG8_SCHED
}
}
#include <hip/hip_bf16.h>
#include <cmath>
namespace attn_body {
using bf16=__hip_bfloat16;
using bf16x8=__attribute__((ext_vector_type(8)))short;
using s16x4=__attribute__((ext_vector_type(4)))short;
using f32x16=__attribute__((ext_vector_type(16)))float;
using u32x4=__attribute__((ext_vector_type(4)))unsigned;
constexpr int BATCH=16,NHEAD=8,SEQ=4096,D=64,DM=512,OPITCH=1024;
constexpr int NW=8,QBLK=32,QB=QBLK*NW,KVBLK=64,NQB=SEQ/QB;
constexpr int ATTN_PITCH=DM, ATTN_UNIT_ROWS=QB;
__device__ __forceinline__ int crow(int r,int hi){return (r&3)+8*(r>>2)+4*hi;}
#define SBAR() __builtin_amdgcn_sched_barrier(0)
__device__ __forceinline__ void cmask(f32x16&p0,f32x16&p1,int jb,int qrel,int hi){
  const float NEG=-INFINITY; int kb=64*jb+4*hi;
  #pragma unroll
  for(int r=0;r<16;++r){int kv=kb+(r&3)+8*(r>>2); if(kv>qrel)p0[r]=NEG; if(kv+32>qrel)p1[r]=NEG;}
}

constexpr int NSLOT=3, SLOTB=8192;
constexpr int LDS_K=0, LDS_V=NSLOT*SLOTB, LDS_WS=2*NSLOT*SLOTB, LDS_OST=LDS_WS+NW*64*4, LDS_CB=LDS_OST+NW*4096, LDS_BYTES=LDS_CB+SEQ*4;
constexpr float C2=0.125f*1.4426950408889634f;
__device__ __forceinline__ void glds16(const void*gsrc,unsigned lds_dst){unsigned keep;
  asm volatile("s_mov_b32 %0, m0\n\ts_mov_b32 m0, %2\n\ts_nop 0\n\tglobal_load_lds_dwordx4 %1, off\n\ts_mov_b32 m0, %0":"=&s"(keep):"v"(gsrc),"s"(lds_dst):"memory");}
__device__ __forceinline__ float max3f(float a,float b,float c){float r;asm("v_max3_f32 %0, %1, %2, %3":"=v"(r):"v"(a),"v"(b),"v"(c));return r;}
__device__ __forceinline__ float max2f(float a,float b){float r;asm("v_max_f32_e32 %0, %1, %2":"=v"(r):"v"(a),"v"(b));return r;}
__device__ __forceinline__ float fadd_s(float a,float b){float r;asm("v_add_f32_e32 %0, %1, %2":"=v"(r):"v"(a),"v"(b));return r;}
__device__ __forceinline__ float fsub_s(float a,float b){float r;asm("v_sub_f32_e32 %0, %1, %2":"=v"(r):"v"(a),"v"(b));return r;}
typedef float f32x2_t __attribute__((ext_vector_type(2))); typedef __bf16 bf16x2_t __attribute__((ext_vector_type(2)));
__device__ __forceinline__ unsigned cvtpk_s(float lo,float hi){f32x2_t v={lo,hi};bf16x2_t b=__builtin_convertvector(v,bf16x2_t);return __builtin_bit_cast(unsigned,b);}
#define WAIT_BAR(N) asm volatile("s_waitcnt vmcnt(" #N ") lgkmcnt(0)\n\ts_barrier":::"memory")

__device__ __forceinline__ void qkt(f32x16&p0,f32x16&p1,const char*Kslot,const bf16x8*qr,const f32x16&negm,int r32,int hi){
  const char*kb=Kslot+hi*1024+r32*16;
  #pragma unroll
  for(int d0=0;d0<4;++d0){
    const bf16x8 b0=*reinterpret_cast<const bf16x8*>(kb+d0*2048);
    const bf16x8 b1=*reinterpret_cast<const bf16x8*>(kb+d0*2048+512);
    p0=__builtin_amdgcn_mfma_f32_32x32x16_bf16(b0,qr[d0],p0,0,0,0);p1=__builtin_amdgcn_mfma_f32_32x32x16_bf16(b1,qr[d0],p1,0,0,0);}
}
typedef __attribute__((address_space(3))) const char* lds_cptr;
typedef short v4i16_t __attribute__((ext_vector_type(4)));
__device__ __forceinline__ void kload8(bf16x8*kf,lds_cptr kp){
  kf[0]=*(const __attribute__((address_space(3))) bf16x8*)(kp);      kf[1]=*(const __attribute__((address_space(3))) bf16x8*)(kp+512);
  kf[2]=*(const __attribute__((address_space(3))) bf16x8*)(kp+2048); kf[3]=*(const __attribute__((address_space(3))) bf16x8*)(kp+2560);
  kf[4]=*(const __attribute__((address_space(3))) bf16x8*)(kp+4096); kf[5]=*(const __attribute__((address_space(3))) bf16x8*)(kp+4608);
  kf[6]=*(const __attribute__((address_space(3))) bf16x8*)(kp+6144); kf[7]=*(const __attribute__((address_space(3))) bf16x8*)(kp+6656);
}
__device__ __forceinline__ void kload2(bf16x8*kf,lds_cptr kp,int j){ kf[2*j]=*(const __attribute__((address_space(3))) bf16x8*)(kp+j*2048); kf[2*j+1]=*(const __attribute__((address_space(3))) bf16x8*)(kp+j*2048+512); }
__device__ __forceinline__ s16x4 vtr(lds_cptr p){ return __builtin_bit_cast(s16x4,__builtin_amdgcn_ds_read_tr16_b64_v4i16((__attribute__((address_space(3))) v4i16_t*)p)); }
__device__ __forceinline__ float rowmax(const f32x16&p0,const f32x16&p1){
  float a=max3f(p0[0],p0[1],p1[0]),b=max3f(p0[2],p0[3],p1[1]);a=max3f(a,p1[2],p1[3]);
  #pragma unroll
  for(int r=4;r<16;r+=4){a=max3f(a,p0[r],p0[r+1]);b=max3f(b,p0[r+2],p0[r+3]);a=max3f(a,p1[r],p1[r+1]);b=max3f(b,p1[r+2],p1[r+3]);}
  const float m=max2f(a,b);
  auto rr=__builtin_amdgcn_permlane32_swap(__float_as_uint(m),__float_as_uint(m),false,false);
  return max2f(__uint_as_float(rr[0]),__uint_as_float(rr[1]));
}
__device__ __forceinline__ void pv(f32x16*o,int vb,bf16x8 pa0,bf16x8 pa1,bf16x8 pa2,bf16x8 pa3){
  #pragma unroll
  for(int d0=0;d0<2;++d0){s16x4 lo[4],hi[4];
    #pragma unroll
    for(int ks=0;ks<4;++ks){
      asm volatile("ds_read_b64_tr_b16 %0,%1 offset:%c2":"=&v"(lo[ks]):"v"(vb),"i"(d0*4096+ks*1024):"memory");
      asm volatile("ds_read_b64_tr_b16 %0,%1 offset:%c2":"=&v"(hi[ks]):"v"(vb),"i"(d0*4096+ks*1024+512):"memory");}
    asm volatile("s_waitcnt lgkmcnt(0)":::"memory");SBAR();
    #define PK(k) (bf16x8){lo[k][0],lo[k][1],lo[k][2],lo[k][3],hi[k][0],hi[k][1],hi[k][2],hi[k][3]}
    o[d0]=__builtin_amdgcn_mfma_f32_32x32x16_bf16(pa0,PK(0),o[d0],0,0,0);
    o[d0]=__builtin_amdgcn_mfma_f32_32x32x16_bf16(pa1,PK(1),o[d0],0,0,0);
    o[d0]=__builtin_amdgcn_mfma_f32_32x32x16_bf16(pa2,PK(2),o[d0],0,0,0);
    o[d0]=__builtin_amdgcn_mfma_f32_32x32x16_bf16(pa3,PK(3),o[d0],0,0,0);
    #undef PK
  }
}


typedef __attribute__((address_space(3))) const float* lds_fptr;
typedef float f32x4a __attribute__((ext_vector_type(4)));
__device__ __forceinline__ void bias_scale(f32x16&p0,f32x16&p1,lds_fptr rk,lds_fptr cb,float mhat,int hi){
  #pragma unroll
  for(int j=0;j<4;++j){
    const f32x4a r0=*(const __attribute__((address_space(3))) f32x4a*)(rk+8*j+4*hi), c0=*(const __attribute__((address_space(3))) f32x4a*)(cb+8*j+4*hi);
    const f32x4a r1=*(const __attribute__((address_space(3))) f32x4a*)(rk+32+8*j+4*hi), c1=*(const __attribute__((address_space(3))) f32x4a*)(cb+32+8*j+4*hi);
    #pragma unroll
    for(int i=0;i<4;++i){ p0[4*j+i]=__builtin_fmaf(p0[4*j+i],r0[i],c0[i])-mhat; p1[4*j+i]=__builtin_fmaf(p1[4*j+i],r1[i],c1[i])-mhat; }
    SBAR();
  }
}
#ifndef ATTN_STORE16
#define ATTN_STORE16(p,v) (*(u32x4*)(p)=(v))
#endif
template<int THRL> __device__ __forceinline__ void attn_unit(int b,int h,int qb,const bf16*Q,const bf16*__restrict__ K,const bf16*__restrict__ V,bf16*O,const float*__restrict__ SSK,const float*__restrict__ CBG,const float*__restrict__ GQ,const float*__restrict__ GK,const _Float16*__restrict__ BG,char*shm){
  int tid=threadIdx.x; asm volatile("":"+v"(tid)::"memory"); const int lane=tid&63,r32=lane&31,hi=lane>>5; const int wid=__builtin_amdgcn_readfirstlane(tid>>6);
  const long rowbase=(long)b*SEQ; const int q0=qb*QB;
  const bf16*Qw=Q+(rowbase+q0+wid*QBLK)*DM+h*D;
  int ts=0;
  { const float*cbg=CBG+(size_t)(b*NHEAD+h)*SEQ; float gqm=fabsf(GQ[lane]),gkm=fabsf(GK[lane]);
    #pragma unroll
    for(int o_=1;o_<64;o_<<=1){ gqm=fmaxf(gqm,__shfl_xor(gqm,o_)); gkm=fmaxf(gkm,__shfl_xor(gkm,o_)); }
    const float B2=64.0f*C2*gqm*gkm*1.1f+1.0f, thr=cbg[q0]-2.0f*B2-46.0f; const int npre=q0/KVBLK;
    const float ve=(lane<npre)?cbg[64*lane+63]:3.0e38f;
    ts=__builtin_popcountll(__ballot(ve<thr))&~1; ts=__builtin_amdgcn_readfirstlane(ts); }
  const bf16*Kh=K+(rowbase+(long)ts*KVBLK)*DM+h*D,*Vh=V+(rowbase+(long)ts*KVBLK)*DM+h*D;
  const lds_cptr shm3=(lds_cptr)shm;
  const unsigned lds0=(unsigned)(uintptr_t)shm;
  float*wsf=(float*)(shm+LDS_WS)+wid*64;
  const bf16*ksrc=Kh+(long)lane*DM+wid*8;
  const bf16*vsrc=Vh+(long)(16*(wid&3)+(lane>>2))*DM+(wid>>2)*32+(lane&3)*8;
  const unsigned kdst=lds0+LDS_K+wid*1024, vdst=lds0+LDS_V+wid*1024;
  #define DMA_K(t,slot) glds16(ksrc+(long)(t)*KVBLK*DM,(unsigned)__builtin_amdgcn_readfirstlane(kdst+(slot)))
  #define DMA_V(t,slot) glds16(vsrc+(long)(t)*KVBLK*DM,(unsigned)__builtin_amdgcn_readfirstlane(vdst+(slot)))
  const int vb0=(int)(lds0+LDS_V)+((lane>>4)&1)*32+(lane&3)*8+(4*hi+((lane&15)>>2))*64;
  const char*Kbase=shm+LDS_K; bf16x8 kf[8];
  const lds_cptr kp0=shm3+LDS_K+hi*1024+r32*16; const lds_cptr vp0=shm3+LDS_V+((lane>>4)&1)*32+(lane&3)*8+(4*hi+((lane&15)>>2))*64;
  const int NT=(q0+QB)/KVBLK-ts;
  { float*cbl=(float*)(shm+LDS_CB); const int nk=q0+QB;
    for(int s=ts*KVBLK+tid;s<nk;s+=NW*64){ cbl[s-ts*KVBLK]=CBG[(size_t)(b*NHEAD+h)*SEQ+s]; } }
  const lds_fptr cb3=(lds_fptr)(shm3+LDS_CB);
  DMA_K(0,0);DMA_V(0,0);DMA_K(1,SLOTB);
  bf16x8 qr[4];
  #pragma unroll
  for(int d0=0;d0<4;++d0)qr[d0]=*reinterpret_cast<const bf16x8*>(&Qw[(long)r32*DM+d0*16+hi*8]);
  { float qss=0.f;
    #pragma unroll
    for(int d0=0;d0<4;++d0)
      #pragma unroll
      for(int j=0;j<8;++j){ const float qv=__uint_as_float(((unsigned)(unsigned short)qr[d0][j])<<16); qss+=qv*qv; }
    qss+=__shfl_xor(qss,32);
    const float qrs=rsqrtf(qss*(1.0f/64.0f)+1e-6f)*C2;
    #pragma unroll
    for(int d0=0;d0<4;++d0){ unsigned w_[4];
      #pragma unroll
      for(int j=0;j<8;j+=2){ const int dd=d0*16+hi*8+j;
        const float v0=__uint_as_float(((unsigned)(unsigned short)qr[d0][j])<<16)*qrs*GQ[dd];
        const float v1=__uint_as_float(((unsigned)(unsigned short)qr[d0][j+1])<<16)*qrs*GQ[dd+1];
        w_[j>>1]=cvtpk_s(v0,v1); }
      qr[d0]=__builtin_bit_cast(bf16x8,(u32x4){w_[0],w_[1],w_[2],w_[3]}); } }
  float mhat=0.f,l_reg=0.f;f32x16 o[2];o[0]=f32x16{};o[1]=f32x16{};const f32x16 negm=f32x16{};
  #define CINIT1(C0_,off_,t_,mh_) do{ const lds_fptr cbp_=cb3+64*(t_)+4*hi+(off_); \
    _Pragma("unroll") for(int j_=0;j_<4;++j_){ const f32x4a c0_=*(const __attribute__((address_space(3))) f32x4a*)(cbp_+8*j_); \
      _Pragma("unroll") for(int i_=0;i_<4;++i_){ C0_[4*j_+i_]=c0_[i_]-(mh_); } } }while(0)
  #define CINIT(C0_,C1_,t_,mh_) do{ CINIT1(C0_,0,t_,mh_); CINIT1(C1_,32,t_,mh_); }while(0)
  const int qrel=wid*QBLK+r32;
  #define CMASK(P0,P1,t) do{int jb_=(t)-(NT-4); if(jb_>=0)cmask(P0,P1,jb_,qrel,hi);}while(0)
  bool resc=false;
  #define START(P0,P1) do{ const float rm=rowmax(P0,P1); resc=false; \
    { const float dl=rm; mhat=fadd_s(mhat,dl); \
      _Pragma("unroll") for(int r=0;r<16;++r){P0[r]=fsub_s(P0[r],dl);P1[r]=fsub_s(P1[r],dl);} \
      } \
    _Pragma("unroll") for(int r=0;r<16;++r)P0[r]=__builtin_amdgcn_exp2f(P0[r]); }while(0)
  #define RESC() do{ if(resc){ asm volatile("s_waitcnt lgkmcnt(0)":::"memory"); \
      _Pragma("unroll") for(int d_=0;d_<2;++d_) _Pragma("unroll") for(int r=0;r<16;++r)o[d_][r]*=wsf[crow(r,hi)]; } }while(0)
  f32x16 pA0,pA1,pB0,pB1;
  int sl_prev=0,sl_cur=0,sl_next=SLOTB;
  #define ROT() do{sl_prev=sl_cur;sl_cur=sl_next;sl_next=(sl_next==(NSLOT-1)*SLOTB)?0:sl_next+SLOTB;}while(0)
  DMA_K(2,2*SLOTB);
  WAIT_BAR(3);
  CINIT(pA0,pA1,0,0.f);qkt(pA0,pA1,Kbase,qr,negm,r32,hi);asm volatile("s_nop 15\n\ts_nop 7":"+v"(pA0),"+v"(pA1));CMASK(pA0,pA1,0);
  START(pA0,pA1);
  _Pragma("unroll") for(int r=0;r<16;++r)pA1[r]=__builtin_amdgcn_exp2f(pA1[r]);
  WAIT_BAR(0);
  DMA_K(3,0);DMA_V(1,SLOTB);
  ROT();
  kload8(kf,kp0+sl_cur);
  WAIT_BAR(2);
  s16x4 vlo[8],vhi[8]; u32x4 pw0,pw1,pw2,pw3;
  #define PKW(P,B) cvtpk_s(P[B],P[B+1])
  #define PAF(k) __builtin_bit_cast(bf16x8,pw##k)
  #define VFR(i) (bf16x8){vlo[i][0],vlo[i][1],vlo[i][2],vlo[i][3],vhi[i][0],vhi[i][1],vhi[i][2],vhi[i][3]}
  #define PIN(x) asm volatile("":"+v"(x))
  #define MX3(a,b,c) __builtin_fmaxf(__builtin_fmaxf((a),(b)),(c))
  #define GAPA(MF,A0,A1,A2,A3,W0,W1,PW) do{ MF; sacc+=A0; sacc+=A1; sacc+=A2; sacc+=A3; PIN(sacc); W0; W1; PIN(PW); SBAR(); }while(0)
  #define EX(v) __builtin_amdgcn_exp2f(v)
  #define GAPB(MF,X,B) do{ MF; X[B]=EX(X[B]); X[B+1]=EX(X[B+1]); X[B+2]=EX(X[B+2]); X[B+3]=EX(X[B+3]); PIN(X); SBAR(); }while(0)
  #define VRD(i) do{ vlo[i]=vtr(vp_+(((i)>>2)*4096+((i)&3)*1024)); vhi[i]=vtr(vp_+(((i)>>2)*4096+((i)&3)*1024+512)); }while(0)
  #define KRD(G,j) do{ if(G){ kload2(kf,kp0+sl_next,j); SBAR(); } }while(0)
  #define STEP(C0,C1,P0,P1,t,GK,GV,GL) do{ SBAR(); \
    const lds_cptr vp_=vp0+sl_prev; CINIT1(C0,0,t,mhat); SBAR(); \
    VRD(0); SBAR(); float sacc=(P0[0]+P0[1]); \
    GAPA(C0=__builtin_amdgcn_mfma_f32_32x32x16_bf16(kf[0],qr[0],C0,0,0,0), P0[2],P0[3],P0[4],P0[5],     pw0[0]=PKW(P0,0), pw0[1]=PKW(P0,2), pw0); \
    CINIT1(C1,32,t,mhat); SBAR(); VRD(4); SBAR(); GAPA(C1=__builtin_amdgcn_mfma_f32_32x32x16_bf16(kf[1],qr[0],C1,0,0,0), P0[6],P0[7],P0[8],P0[9],     pw0[2]=PKW(P0,4), pw0[3]=PKW(P0,6), pw0); \
    VRD(1); SBAR(); GAPA(C0=__builtin_amdgcn_mfma_f32_32x32x16_bf16(kf[2],qr[1],C0,0,0,0),   P0[10],P0[11],P0[12],P0[13], pw1[0]=PKW(P0,8), pw1[1]=PKW(P0,10), pw1); \
    VRD(5); SBAR(); GAPA(C1=__builtin_amdgcn_mfma_f32_32x32x16_bf16(kf[3],qr[1],C1,0,0,0),   P0[14],P0[15],P1[0],P1[1],   pw1[2]=PKW(P0,12),pw1[3]=PKW(P0,14), pw1); \
    VRD(2); SBAR(); GAPA(C0=__builtin_amdgcn_mfma_f32_32x32x16_bf16(kf[4],qr[2],C0,0,0,0),   P1[2],P1[3],P1[4],P1[5],     pw2[0]=PKW(P1,0), pw2[1]=PKW(P1,2), pw2); \
    VRD(6); SBAR(); GAPA(C1=__builtin_amdgcn_mfma_f32_32x32x16_bf16(kf[5],qr[2],C1,0,0,0),   P1[6],P1[7],P1[8],P1[9],     pw2[2]=PKW(P1,4), pw2[3]=PKW(P1,6), pw2); \
    VRD(3); SBAR(); GAPA(C0=__builtin_amdgcn_mfma_f32_32x32x16_bf16(kf[6],qr[3],C0,0,0,0),   P1[10],P1[11],P1[12],P1[13], pw3[0]=PKW(P1,8), pw3[1]=PKW(P1,10), pw3); \
    VRD(7); SBAR(); GAPA(C1=__builtin_amdgcn_mfma_f32_32x32x16_bf16(kf[7],qr[3],C1,0,0,0),   P1[14],P1[15],0.f,0.f,       pw3[2]=PKW(P1,12),pw3[3]=PKW(P1,14), pw3); \
    l_reg+=sacc; \
    if(GK){DMA_K((t)+3,sl_cur);} if(GV){DMA_V((t)+1,sl_next);} \
    CMASK(C0,C1,t); \
    { float a=MX3(C0[0],C0[1],C1[0]),b=MX3(C0[2],C0[3],C1[1]); a=MX3(a,C1[2],C1[3]); \
      _Pragma("unroll") for(int r=4;r<16;r+=4){a=MX3(a,C0[r],C0[r+1]);b=MX3(b,C0[r+2],C0[r+3]);a=MX3(a,C1[r],C1[r+1]);b=MX3(b,C1[r+2],C1[r+3]);} \
      float rm=__builtin_fmaxf(a,b); { auto rr=__builtin_amdgcn_permlane32_swap(__float_as_uint(rm),__float_as_uint(rm),false,false); rm=__builtin_fmaxf(__uint_as_float(rr[0]),__uint_as_float(rr[1])); } \
      resc=false; \
      if(__builtin_expect(__any(rm>(float)THRL),0)){ const float dl=__builtin_fmaxf(rm,0.f); mhat+=dl; \
        _Pragma("unroll") for(int r=0;r<16;++r){C0[r]-=dl;C1[r]-=dl;} \
        const float f=__builtin_amdgcn_exp2f(-dl); l_reg*=f; if(hi==0)wsf[r32]=f; resc=true; } } \
    SBAR(); \
    GAPB(o[0]=__builtin_amdgcn_mfma_f32_32x32x16_bf16(PAF(0),VFR(0),o[0],0,0,0), C0,0); \
    GAPB(o[1]=__builtin_amdgcn_mfma_f32_32x32x16_bf16(PAF(0),VFR(4),o[1],0,0,0), C0,4); \
    KRD(GL,0); GAPB(o[0]=__builtin_amdgcn_mfma_f32_32x32x16_bf16(PAF(1),VFR(1),o[0],0,0,0), C0,8); \
    KRD(GL,1); GAPB(o[1]=__builtin_amdgcn_mfma_f32_32x32x16_bf16(PAF(1),VFR(5),o[1],0,0,0), C0,12); \
    KRD(GL,2); GAPB(o[0]=__builtin_amdgcn_mfma_f32_32x32x16_bf16(PAF(2),VFR(2),o[0],0,0,0), C1,0); \
    KRD(GL,3); GAPB(o[1]=__builtin_amdgcn_mfma_f32_32x32x16_bf16(PAF(2),VFR(6),o[1],0,0,0), C1,4); \
    GAPB(o[0]=__builtin_amdgcn_mfma_f32_32x32x16_bf16(PAF(3),VFR(3),o[0],0,0,0), C1,8); \
    GAPB(o[1]=__builtin_amdgcn_mfma_f32_32x32x16_bf16(PAF(3),VFR(7),o[1],0,0,0), C1,12); \
    }while(0)
  int t=1;
  #undef CMASK
  #define CMASK(P0,P1,t) do{}while(0)
  for(;t+5<NT;t+=2){
    STEP(pB0,pB1,pA0,pA1,t,true,true,true);     WAIT_BAR(2); RESC(); ROT();
    STEP(pA0,pA1,pB0,pB1,t+1,true,true,true);   WAIT_BAR(2); RESC(); ROT();
  }
  #undef CMASK
  #define CMASK(P0,P1,t) do{int jb_=(t)-(NT-4); if(jb_>=0)cmask(P0,P1,jb_,qrel,hi);}while(0)
  #define ENDW(tt) do{ if((tt)+3<NT){WAIT_BAR(2);} else if((tt)+2<NT){WAIT_BAR(1);} else {WAIT_BAR(0);} }while(0)
  for(;t+1<NT;t+=2){
    STEP(pB0,pB1,pA0,pA1,t,(t+3<NT),(t+1<NT),(t+1<NT));       ENDW(t);   RESC(); ROT();
    STEP(pA0,pA1,pB0,pB1,t+1,(t+4<NT),(t+2<NT),(t+2<NT));     ENDW(t+1); RESC(); ROT();
  }
  STEP(pB0,pB1,pA0,pA1,NT-1,false,false,false); RESC();
  { float sacc=pB0[0]+pB0[1]; _Pragma("unroll") for(int r=2;r<16;++r)sacc+=pB0[r]; _Pragma("unroll") for(int r=0;r<16;++r)sacc+=pB1[r]; l_reg+=sacc;
    pw0=(u32x4){PKW(pB0,0),PKW(pB0,2),PKW(pB0,4),PKW(pB0,6)};pw1=(u32x4){PKW(pB0,8),PKW(pB0,10),PKW(pB0,12),PKW(pB0,14)};pw2=(u32x4){PKW(pB1,0),PKW(pB1,2),PKW(pB1,4),PKW(pB1,6)};pw3=(u32x4){PKW(pB1,8),PKW(pB1,10),PKW(pB1,12),PKW(pB1,14)};
    SBAR(); pv(o,vb0+sl_cur,PAF(0),PAF(1),PAF(2),PAF(3)); }
  #undef PKW
  #undef PAF
  #undef VFR
  #undef PIN
  #undef MX3
  #undef GAPA
  #undef GAPB
  #undef EX
  #undef VRD
  #undef KRD
  #undef STEP
  #undef ENDW
  {auto rr=__builtin_amdgcn_permlane32_swap(__float_as_uint(l_reg),__float_as_uint(l_reg),false,false);l_reg=__uint_as_float(rr[0])+__uint_as_float(rr[1]);}
  if(hi==0)wsf[32+r32]=l_reg;asm volatile("s_waitcnt lgkmcnt(0)":::"memory");
  float rli[16];
  #pragma unroll
  for(int r=0;r<16;++r)rli[r]=__builtin_amdgcn_rcpf(wsf[32+crow(r,hi)]);
  bf16*Ow=O+(rowbase+q0+wid*QBLK)*OPITCH+h*D; const _Float16*Gw=BG+(rowbase+q0+wid*QBLK)*DM+h*D;
  { bf16*stg=(bf16*)(shm+LDS_OST)+wid*2048;
    typedef _Float16 h8_t __attribute__((ext_vector_type(8))); h8_t ggv[4];
    #pragma unroll
    for(int i=0;i<4;++i)ggv[i]=*(const h8_t*)(Gw+(long)(i*8+(lane>>3))*DM+(lane&7)*8);
    #pragma unroll
    for(int r=0;r<16;++r){const int orow=crow(r,hi);
      #pragma unroll
      for(int d0=0;d0<2;++d0)stg[orow*64+d0*32+r32]=__float2bfloat16(o[d0][r]*rli[r]);}
    asm volatile("s_waitcnt lgkmcnt(0)":::"memory");
    #pragma unroll
    for(int i=0;i<4;++i){const int row=i*8+(lane>>3),ch=lane&7; const u32x4 v=*(const u32x4*)(stg+row*64+ch*8);
      const h8_t gg=ggv[i]; u32x4 w;
      #pragma unroll
      for(int j=0;j<4;++j){ const float lo=__uint_as_float(v[j]<<16)*(float)gg[2*j], hi_=__uint_as_float(v[j]&0xffff0000u)*(float)gg[2*j+1]; w[j]=cvtpk_s(lo,hi_); }
      ATTN_STORE16(Ow+(long)row*OPITCH+ch*8,w);} }
  asm volatile("s_waitcnt lgkmcnt(0)\n\ts_barrier":::"memory");
  #undef DMA_K
  #undef DMA_V
  #undef CINIT
  #undef CINIT1
  #undef CMASK
  #undef START
  #undef RESC
  #undef ROT
}
constexpr int ATTN_LDS_BYTES=LDS_BYTES;
struct AttnTensors { const bf16* Q; const bf16* K; const bf16* V; bf16* O; const float* SSK; const float* CBG; const float* GQ; const float* GK; const _Float16* BG; };
struct AttnUnit { int bh; int qb; };
struct StaticOrder {
  int vcu,nmine,base;
  __device__ __forceinline__ explicit StaticOrder(int grid,int block):vcu(block),nmine(block>=128?14:2),base(block>=128?0:1792){}
  __device__ __forceinline__ bool next(int i,AttnUnit&u)const{ if(i>=nmine)return false; const int L=2047-(base+i*128+(vcu&127)); u.bh=L>>4; u.qb=L&15; return true; }
  __device__ __forceinline__ void a_ready(const AttnUnit&)const{}
  __device__ __forceinline__ void done(const AttnUnit&)const{}
};
template<class Sched,int THRL=8> __device__ __forceinline__ void attn_phase(char*lds,const AttnTensors&T,const Sched&S){
  AttnUnit u;
  for(int i=0;S.next(i,u);++i){ S.a_ready(u); attn_unit<THRL>(u.bh/NHEAD,u.bh%NHEAD,u.qb,T.Q,T.K,T.V,T.O,T.SSK,T.CBG,T.GQ,T.GK,T.BG,lds); S.done(u); }
}
#undef SBAR
#undef WAIT_BAR
}
#define DI __device__ __forceinline__
#define LAS __attribute__((address_space(3)))
typedef unsigned short u16;
typedef float f32x4 __attribute__((ext_vector_type(4)));
typedef unsigned u32x4 __attribute__((ext_vector_type(4)));
typedef unsigned u32x2 __attribute__((ext_vector_type(2)));
typedef float f32x2 __attribute__((ext_vector_type(2)));
typedef _Float16 h8 __attribute__((ext_vector_type(8)));
typedef _Float16 h4 __attribute__((ext_vector_type(4)));
typedef _Float16 h2 __attribute__((ext_vector_type(2)));
constexpr int NB = 16, SQ = 4096, DMODEL = 1024, TT = NB * SQ, DFF = 4096;
constexpr size_t MiB = 1u << 20;
constexpr size_t WS_LB = 0;
constexpr size_t WS_BAR = 65536, BAR_BYTES = 16384;
constexpr size_t WS_WIN = 1 * MiB, WS_WOUT = 9 * MiB, WS_WUP0 = 11 * MiB, WS_WUP1 = 19 * MiB, WS_WD0 = 27 * MiB, WS_WD1 = 35 * MiB,
                 WS_WBIG = 43 * MiB, WS_WLORA = 49 * MiB, WS_W2 = 56 * MiB, WS_WO = 57 * MiB;
constexpr size_t WS_LF = 60 * MiB, WS_CB = 62 * MiB, WS_SSK = 64 * MiB, WS_SS = 68 * MiB;
constexpr size_t WS_XN = 80 * MiB;
constexpr size_t WS_PROJ = 210 * MiB;
constexpr size_t WS_LH = 978 * MiB;
constexpr size_t WS_RKV = 594 * MiB;
constexpr size_t WS_WAG = 210 * MiB;
constexpr size_t WS_OA = 722 * MiB;
constexpr size_t WS_HB = 850 * MiB;
constexpr size_t WS_END = 1010 * MiB;
constexpr size_t PSTR = (size_t)TT * 512;
constexpr size_t RSTR = (size_t)TT * 1024;
constexpr int LDS_TOTAL = 147456;

typedef __bf16 bf16x2_k __attribute__((ext_vector_type(2)));
DI unsigned pk_bf16(float lo, float hi) { typedef float f2_ __attribute__((ext_vector_type(2))); const f2_ v = {lo, hi}; return __builtin_bit_cast(unsigned, __builtin_convertvector(v, bf16x2_k)); }
DI unsigned pk_f16(float lo, float hi) { h2 v = {(_Float16)lo, (_Float16)hi}; return __builtin_bit_cast(unsigned, v); }
DI float sigm(float x) { return __builtin_amdgcn_rcpf(1.0f + __expf(-x)); }
DI float bf2f(unsigned short b) { return __uint_as_float(((unsigned)b) << 16); }
template <int CTRL> DI float dpp_f(float x) { return __builtin_bit_cast(float, __builtin_amdgcn_update_dpp(0, __builtin_bit_cast(int, x), CTRL, 0xF, 0xF, true)); }
DI float red8(float x) { x += dpp_f<0xB1>(x); x += dpp_f<0x4E>(x); x += dpp_f<0x141>(x); return x; }
DI float red16(float x) { x = red8(x); x += dpp_f<0x140>(x); return x; }
DI float wave_sum(float v) {
#pragma unroll
    for (int o = 1; o < 64; o <<= 1) v += __shfl_xor(v, o);
    return v;
}
DI void st8_bf16(u16* p, const f32x4 a, const f32x4 b) { u32x4 w; w.x = pk_bf16(a[0], a[1]); w.y = pk_bf16(a[2], a[3]); w.z = pk_bf16(b[0], b[1]); w.w = pk_bf16(b[2], b[3]); *(u32x4*)p = w; }
DI void st8_bf16_nt(u16* p, const f32x4 a, const f32x4 b) { u32x4 w; w.x = pk_bf16(a[0], a[1]); w.y = pk_bf16(a[2], a[3]); w.z = pk_bf16(b[0], b[1]); w.w = pk_bf16(b[2], b[3]); __builtin_nontemporal_store(w, (u32x4*)p); }
DI void st8_f16(u16* p, const f32x4 a, const f32x4 b) { u32x4 w; w.x = pk_f16(a[0], a[1]); w.y = pk_f16(a[2], a[3]); w.z = pk_f16(b[0], b[1]); w.w = pk_f16(b[2], b[3]); *(u32x4*)p = w; }

struct EpiArgs { u16* o0; u16* o1; const float* p0; const float* p1; float* f0; float* ss; };
template <int MODE> struct Epi {
    static constexpr bool PERM = true, AFTER_DRAIN = false;
    EpiArgs a; const LAS float* rs = nullptr; mutable int ucnt = 0;
    DI void operator()(const f32x4 (&acc)[2][2][4][2], const pg8::Unit& u, int wr, int wc, int fr, int fq) const {
        const int rbase = u.pm * 256 + wr * 64 + fr;
        if constexpr (MODE == 0) {
            const int grp = u.pn >> 1, cg0 = (u.pn & 1) * 256 + wc * 32 + 8 * fq;
            u16* base = a.o0 + (size_t)grp * PSTR;
            if (grp == 5) {
                LAS float* xch = (LAS float*)rs;
                float ps[2][4][2];
#pragma unroll
                for (int ai = 0; ai < 2; ++ai)
#pragma unroll
                    for (int m = 0; m < 4; ++m)
#pragma unroll
                        for (int bj = 0; bj < 2; ++bj) { const f32x4 v0 = acc[ai][bj][m][0], v1 = acc[ai][bj][m][1];
                            float s = (v0[0] * v0[0] + v0[1] * v0[1]) + (v0[2] * v0[2] + v0[3] * v0[3]) + (v1[0] * v1[0] + v1[1] * v1[1]) + (v1[2] * v1[2] + v1[3] * v1[3]);
                            s += __shfl_xor(s, 16); s += __shfl_xor(s, 32); ps[ai][m][bj] = s;
                            if (fq == 0) xch[(ai * 128 + wr * 64 + m * 16 + fr) * 8 + bj * 4 + wc] = s; }
                asm volatile("s_waitcnt lgkmcnt(0)" ::: "memory"); __builtin_amdgcn_s_barrier(); asm volatile("" ::: "memory");
                const f32x4 gk0 = *(const f32x4*)(a.p1 + (wc & 1) * 32 + 8 * fq), gk1 = *(const f32x4*)(a.p1 + (wc & 1) * 32 + 8 * fq + 4);
#pragma unroll
                for (int ai = 0; ai < 2; ++ai)
#pragma unroll
                    for (int m = 0; m < 4; ++m) { const int row = rbase + ai * 128 + m * 16;
#pragma unroll
                        for (int bj = 0; bj < 2; ++bj) { const float tot = ps[ai][m][bj] + xch[(ai * 128 + wr * 64 + m * 16 + fr) * 8 + bj * 4 + (wc ^ 1)];
                            const float rstd = rsqrtf(tot * (1.0f / 64.0f) + 1e-6f);
                            st8_bf16(base + (size_t)row * 512 + cg0 + bj * 128, acc[ai][bj][m][0] * rstd * gk0, acc[ai][bj][m][1] * rstd * gk1); } }
                return;
            }
            f32x4 lb[2][2];
#pragma unroll
            for (int bj = 0; bj < 2; ++bj) { lb[bj][0] = *(const f32x4*)(a.p0 + cg0 + bj * 128); lb[bj][1] = *(const f32x4*)(a.p0 + cg0 + bj * 128 + 4); }
#pragma unroll
            for (int ai = 0; ai < 2; ++ai)
#pragma unroll
                for (int m = 0; m < 4; ++m) {
                    const int row = rbase + ai * 128 + m * 16;
#pragma unroll
                    for (int bj = 0; bj < 2; ++bj) {
                        f32x4 v0 = acc[ai][bj][m][0], v1 = acc[ai][bj][m][1];
                        u16* dst = base + (size_t)row * 512 + cg0 + bj * 128;
                        if (grp == 0 || grp == 3) {
#pragma unroll
                            for (int j = 0; j < 4; ++j) { v0[j] = v0[j] * sigm(v0[j]); v1[j] = v1[j] * sigm(v1[j]); }
                            st8_f16(dst, v0, v1);
                        } else if (grp == 1) {
#pragma unroll
                            for (int j = 0; j < 4; ++j) { v0[j] = lb[bj][0][j] + (1.0f - lb[bj][0][j]) * sigm(v0[j]); v1[j] = lb[bj][1][j] + (1.0f - lb[bj][1][j]) * sigm(v1[j]); }
                            st8_f16(dst, v0, v1);
                        } else if (grp == 2) { st8_f16(dst, v0, v1);
                        } else if (grp == 7) {
#pragma unroll
                            for (int j = 0; j < 4; ++j) { v0[j] = sigm(v0[j]); v1[j] = sigm(v1[j]); }
                            st8_f16(dst, v0, v1);
                        } else {
                            st8_bf16(dst, v0, v1);
                        }
                    }
                }
        } else if constexpr (MODE == 1) {
            const int col = u.pn * 256 + wc * 32 + 8 * fq;
#pragma unroll
            for (int ai = 0; ai < 2; ++ai) {
                f32x4 r0[4][2], r1[4][2];
                if (a.p0) {
#pragma unroll
                    for (int m = 0; m < 4; ++m)
#pragma unroll
                        for (int bj = 0; bj < 2; ++bj) { const size_t off = (size_t)(rbase + ai * 128 + m * 16) * 1024 + col + bj * 128; r0[m][bj] = *(const f32x4*)(a.p0 + off); r1[m][bj] = *(const f32x4*)(a.p0 + off + 4); }
                } else {
                    u32x4 w[4][2];
#pragma unroll
                    for (int m = 0; m < 4; ++m)
#pragma unroll
                        for (int bj = 0; bj < 2; ++bj) w[m][bj] = *(const u32x4*)(a.o1 + (size_t)(rbase + ai * 128 + m * 16) * 1024 + col + bj * 128);
#pragma unroll
                    for (int m = 0; m < 4; ++m)
#pragma unroll
                        for (int bj = 0; bj < 2; ++bj) { const u32x4 q = w[m][bj];
                            r0[m][bj] = (f32x4){__uint_as_float(q.x << 16), __uint_as_float(q.x & 0xffff0000u), __uint_as_float(q.y << 16), __uint_as_float(q.y & 0xffff0000u)};
                            r1[m][bj] = (f32x4){__uint_as_float(q.z << 16), __uint_as_float(q.z & 0xffff0000u), __uint_as_float(q.w << 16), __uint_as_float(q.w & 0xffff0000u)}; }
                }
#pragma unroll
                for (int m = 0; m < 4; ++m) {
                    const int row = rbase + ai * 128 + m * 16; float s = 0.f;
#pragma unroll
                    for (int bj = 0; bj < 2; ++bj) {
                        const size_t off = (size_t)row * 1024 + col + bj * 128;
                        const f32x4 v0 = acc[ai][bj][m][0] + r0[m][bj], v1 = acc[ai][bj][m][1] + r1[m][bj];
                        if (a.f0) { *(f32x4*)(a.f0 + off) = v0; *(f32x4*)(a.f0 + off + 4) = v1; }
                        if (a.o0) st8_bf16(a.o0 + off, v0, v1);
                        s += (v0[0] * v0[0] + v0[1] * v0[1]) + (v0[2] * v0[2] + v0[3] * v0[3]) + (v1[0] * v1[0] + v1[1] * v1[1]) + (v1[2] * v1[2] + v1[3] * v1[3]);
                    }
                    if (a.ss) { s += __shfl_xor(s, 16); s += __shfl_xor(s, 32); if (fq == 0) a.ss[(size_t)row * 16 + u.pn * 4 + wc] = s; }
                }
            }
        } else if constexpr (MODE == 2) {
            const int col = u.pn * 256 + wc * 32 + 8 * fq;
#pragma unroll
            for (int ai = 0; ai < 2; ++ai)
#pragma unroll
                for (int m = 0; m < 4; ++m) {
                    const int row = rbase + ai * 128 + m * 16;
                    const float rstd = rs[(ucnt & 1) * 256 + ai * 128 + wr * 64 + m * 16 + fr];
#pragma unroll
                    for (int bj = 0; bj < 2; ++bj) {
                        f32x4 v0 = acc[ai][bj][m][0], v1 = acc[ai][bj][m][1];
#pragma unroll
                        for (int j = 0; j < 4; ++j) { float t0 = fmaxf(v0[j], 0.f) * rstd, t1 = fmaxf(v1[j], 0.f) * rstd; v0[j] = t0 * t0; v1[j] = t1 * t1; }
                        st8_bf16(a.o0 + (size_t)row * 4096 + col + bj * 128, v0, v1);
                    }
                }
            ++ucnt;
        } else if constexpr (MODE == 3 || MODE == 5) {
#pragma unroll
            for (int ai = 0; ai < 2; ++ai)
#pragma unroll
                for (int m = 0; m < 4; ++m) {
                    const int row = rbase + ai * 128 + m * 16;
#pragma unroll
                    for (int bj = 0; bj < 2; ++bj) {
                        f32x4 v0 = acc[ai][bj][m][0], v1 = acc[ai][bj][m][1];
                        if (MODE == 3) { st8_f16(a.o0 + (size_t)(u.pn >> 2) * RSTR + (size_t)row * 1024 + (u.pn & 3) * 256 + bj * 128 + wc * 32 + 8 * fq, v0, v1); }
                        else {
                            if (bj == 1) {
#pragma unroll
                                for (int j = 0; j < 4; ++j) { v0[j] = sigm(v0[j]); v1[j] = sigm(v1[j]); }
                            } else if (wc < 2) {
#pragma unroll
                                for (int j = 0; j < 4; ++j) { v0[j] = 1.0f - 2.0f * __builtin_amdgcn_rcpf(__expf(2.0f * v0[j]) + 1.0f); v1[j] = 1.0f - 2.0f * __builtin_amdgcn_rcpf(__expf(2.0f * v1[j]) + 1.0f); }
                            }
                            st8_bf16(a.o1 + (size_t)row * 256 + bj * 128 + wc * 32 + 8 * fq, v0, v1);
                        }
                    }
                }
        } else if constexpr (MODE == 4) {
            const int grp = u.pn >> 2, c0 = (u.pn & 3) * 256 + wc * 32 + 8 * fq;
            const float* bias = grp == 0 ? a.p0 : a.p1;
#pragma unroll
            for (int ai = 0; ai < 2; ++ai)
#pragma unroll
                for (int m = 0; m < 4; ++m) {
                    const int row = rbase + ai * 128 + m * 16;
#pragma unroll
                    for (int bj = 0; bj < 2; ++bj) {
                        f32x4 bv[2][2]; bv[bj][0] = *(const f32x4*)(bias + c0 + bj * 128); bv[bj][1] = *(const f32x4*)(bias + c0 + bj * 128 + 4);
                        f32x4 v0 = acc[ai][bj][m][0], v1 = acc[ai][bj][m][1]; if (grp < 2) { v0 = v0 + bv[bj][0]; v1 = v1 + bv[bj][1]; }
                        asm volatile("" : "+v"(v0), "+v"(v1));
                        if (grp == 0) {
#pragma unroll
                            for (int j = 0; j < 4; ++j) { v0[j] = __expf(-0.60653066f * sigm(v0[j])); v1[j] = __expf(-0.60653066f * sigm(v1[j])); }
                        } else if (grp == 1) {
#pragma unroll
                            for (int j = 0; j < 4; ++j) { v0[j] = sigm(v0[j]); v1[j] = sigm(v1[j]); }
                        }
                        st8_f16(a.o0 + (size_t)grp * RSTR + (size_t)row * 1024 + c0 + bj * 128, v0, v1);
                    }
                }
        }
    }
};
DI void tr_item(const float* __restrict__ W, int ldw, int col0w, int Nn, u16* WT, int ldt, int row_off, int kcol_off, const float* __restrict__ sc, int scmode, LAS float* scr, int item, int lane) {
    const int nblk = Nn / 32, kb = item / nblk, nb = item % nblk, k0 = 64 * kb, n0 = 32 * nb;
#pragma unroll 8
    for (int i = 0; i < 32; ++i) { const int kk = 2 * i + (lane >> 5); float s = 1.0f; if (scmode == 1) s = sc[k0 + kk]; else if (scmode == 2) s = 1.0f - sc[k0 + kk];
        scr[kk * 33 + (lane & 31)] = W[(size_t)(k0 + kk) * ldw + col0w + n0 + (lane & 31)] * s; }
    asm volatile("s_waitcnt lgkmcnt(0)" ::: "memory");
    const int c = lane & 7;
#pragma unroll
    for (int j = 0; j < 4; ++j) { const int n = (lane >> 3) + 8 * j; const LAS float* s = scr + (8 * c) * 33 + n;
        u32x4 o; o.x = pk_bf16(s[0 * 33], s[1 * 33]); o.y = pk_bf16(s[2 * 33], s[3 * 33]); o.z = pk_bf16(s[4 * 33], s[5 * 33]); o.w = pk_bf16(s[6 * 33], s[7 * 33]);
        *(u32x4*)(WT + (size_t)(row_off + n0 + n) * ldt + kcol_off + k0 + 8 * c) = o; }
    asm volatile("s_waitcnt lgkmcnt(0)" ::: "memory");
}

struct Args { const float* in[28]; float* out; unsigned char* ws; };

DI void p0_prologue(const Args& A, LAS unsigned char* lds, int tid, int lane, int wave) {
    unsigned char* ws = A.ws;
    LAS float* scr = (LAS float*)(lds + wave * 16384);
    const int gw = blockIdx.x * 8 + wave, NGW = gridDim.x * 8;
    u16* WIN = (u16*)(ws + WS_WIN); u16* WOUT = (u16*)(ws + WS_WOUT); u16* WUP0 = (u16*)(ws + WS_WUP0); u16* WUP1 = (u16*)(ws + WS_WUP1);
    u16* WD0 = (u16*)(ws + WS_WD0); u16* WD1 = (u16*)(ws + WS_WD1); u16* WBIG = (u16*)(ws + WS_WBIG); u16* WLORA = (u16*)(ws + WS_WLORA); u16* W2 = (u16*)(ws + WS_W2); u16* WO = (u16*)(ws + WS_WO);
    const float* mu = A.in[10];
    constexpr int I_IN = 16 * 128, I_SQ = 16 * 32, I_UP = 16 * 128, I_DN = 64 * 32, I_L64 = 16 * 2, I_L128 = 16 * 4, I_W2 = 32, I_G2 = 64;
    constexpr int NITEMS = I_IN + I_SQ + 2 * I_UP + 2 * I_DN + 3 * I_SQ + 4 * I_L64 + 2 * I_L128 + 2 * I_W2 + I_G2 + I_SQ;
    for (int it = gw; it < NITEMS; it += NGW) {
        int r = it;
        if (r < I_IN) { tr_item(A.in[3], 4104, 0, 4096, WIN, 1024, 0, 0, nullptr, 0, scr, r, lane); continue; } r -= I_IN;
        if (r < I_SQ) { tr_item(A.in[9], 1024, 0, 1024, WOUT, 1024, 0, 0, nullptr, 0, scr, r, lane); continue; } r -= I_SQ;
        if (r < I_UP) { tr_item(A.in[26], 4096, 0, 4096, WUP0, 1024, 0, 0, A.in[2], 1, scr, r, lane); continue; } r -= I_UP;
        if (r < I_UP) { tr_item(A.in[26] + (size_t)1024 * 4096, 4096, 0, 4096, WUP1, 1024, 0, 0, A.in[2] + 1024, 1, scr, r, lane); continue; } r -= I_UP;
        if (r < I_DN) { tr_item(A.in[27], 1024, 0, 1024, WD0, 4096, 0, 0, nullptr, 0, scr, r, lane); continue; } r -= I_DN;
        if (r < I_DN) { tr_item(A.in[27] + (size_t)4096 * 1024, 1024, 0, 1024, WD1, 4096, 0, 0, nullptr, 0, scr, r, lane); continue; } r -= I_DN;
        if (r < 3 * I_SQ) { const int i3 = r / I_SQ;
            tr_item(A.in[11] + (size_t)i3 * 1024 * 1024, 1024, 0, 1024, WBIG, 1024, i3 * 1024, 0, nullptr, 0, scr, r % I_SQ, lane); continue; } r -= 3 * I_SQ;
        if (r < 2 * I_L64) { const int half = r / I_L64; tr_item(A.in[13], 64, 0, 64, WLORA, 2048, 0, half * 1024, mu + 1 * 1024, half ? 1 : 2, scr, r % I_L64, lane); continue; } r -= 2 * I_L64;
        if (r < 2 * I_L64) { const int half = r / I_L64; tr_item(A.in[16], 64, 0, 64, WLORA, 2048, 64, half * 1024, mu + 4 * 1024, half ? 1 : 2, scr, r % I_L64, lane); continue; } r -= 2 * I_L64;
        if (r < 2 * I_L128) { const int half = r / I_L128; tr_item(A.in[18], 128, 0, 128, WLORA, 2048, 128, half * 1024, mu + 5 * 1024, half ? 1 : 2, scr, r % I_L128, lane); continue; } r -= 2 * I_L128;
        if (r < I_W2) { tr_item(A.in[14], 1024, 0, 1024, W2, 128, 0, 0, nullptr, 0, scr, r, lane); continue; } r -= I_W2;
        if (r < I_W2) { tr_item(A.in[17], 1024, 0, 1024, W2, 128, 1024, 0, nullptr, 0, scr, r, lane); continue; } r -= I_W2;
        if (r < I_G2) { tr_item(A.in[19], 1024, 0, 1024, W2, 128, 2048, 0, nullptr, 0, scr, r, lane); continue; } r -= I_G2;
        tr_item(A.in[25], 1024, 0, 1024, WO, 1024, 0, 0, nullptr, 0, scr, r, lane);
    }
    for (int i = blockIdx.x * 512 + tid; i < 2048 * 8; i += gridDim.x * 512) { const int n = i >> 3, c = i & 7; *(u32x4*)(W2 + (size_t)n * 128 + 64 + c * 8) = (u32x4){0u, 0u, 0u, 0u}; }
    if (blockIdx.x == 0) { const float* G = A.in[4]; float* LB = (float*)(ws + WS_LB); const int c = tid;
        const float g0 = G[c], g1 = G[512 + c], g2 = G[1024 + c], mx = fmaxf(g0, fmaxf(g1, g2)); const float e0 = __expf(g0 - mx), e1 = __expf(g1 - mx), e2 = __expf(g2 - mx); LB[c] = e0 / (e0 + e1 + e2); }
    {
        const float* x = A.in[0]; const float* g = A.in[1]; const float* win = A.in[3]; const float* fb = A.in[6];
        u16* XN = (u16*)(ws + WS_XN); float* LF = (float*)(ws + WS_LF);
        f32x4 gv[4], wv0[4][4], wv1[4][4];
#pragma unroll
        for (int j = 0; j < 4; ++j) { gv[j] = *(const f32x4*)(g + 4 * lane + 256 * j);
#pragma unroll
            for (int e = 0; e < 4; ++e) { const float* wr_ = win + (size_t)(4 * lane + 256 * j + e) * 4104 + 4096; wv0[j][e] = *(const f32x4*)wr_; wv1[j][e] = *(const f32x4*)(wr_ + 4); } }
        asm volatile("" ::: "memory");
        for (int m = gw; m < TT; m += NGW) {
            const f32x4* xr = (const f32x4*)(x + (size_t)m * 1024) + lane;
            f32x4 v[4]; float s = 0.f;
#pragma unroll
            for (int j = 0; j < 4; ++j) { v[j] = xr[64 * j]; s += (v[j][0] * v[j][0] + v[j][1] * v[j][1]) + (v[j][2] * v[j][2] + v[j][3] * v[j][3]); }
            const float rstd = rsqrtf(wave_sum(s) * (1.0f / 1024.0f) + 1e-6f);
            float pf[8];
#pragma unroll
            for (int q = 0; q < 8; ++q) pf[q] = 0.f;
            u32x2* o8 = (u32x2*)(XN + (size_t)m * 1024) + lane;
#pragma unroll
            for (int j = 0; j < 4; ++j) { v[j] = v[j] * rstd * gv[j]; u32x2 w; w.x = pk_bf16(v[j][0], v[j][1]); w.y = pk_bf16(v[j][2], v[j][3]); o8[64 * j] = w;
#pragma unroll
                for (int e = 0; e < 4; ++e) { const f32x4 w0 = wv0[j][e], w1 = wv1[j][e];
                    pf[0] += v[j][e] * w0[0]; pf[1] += v[j][e] * w0[1]; pf[2] += v[j][e] * w0[2]; pf[3] += v[j][e] * w0[3]; pf[4] += v[j][e] * w1[0]; pf[5] += v[j][e] * w1[1]; pf[6] += v[j][e] * w1[2]; pf[7] += v[j][e] * w1[3]; } }
#pragma unroll
            for (int q = 0; q < 8; ++q) pf[q] = wave_sum(pf[q]);
            if (lane < 8) { float z = pf[0];
#pragma unroll
                for (int q = 1; q < 8; ++q) z = (lane == q) ? pf[q] : z;
                z += fb[lane]; LF[(size_t)m * 8 + lane] = fminf(z, 0.f) - log1pf(__expf(-fabsf(z))); }
        }
    }
}

DI void fox_cumsum(const Args& A, LAS unsigned char* lds, int bh, int tid, int lane, int wave) {
    const float* LF = (const float*)(A.ws + WS_LF); float* CB = (float*)(A.ws + WS_CB);
    const int b = bh >> 3, h = bh & 7; LAS float* tot = (LAS float*)lds;
    float v[8]; float run = 0.f;
#pragma unroll
    for (int i = 0; i < 8; ++i) { run += LF[((size_t)b * SQ + tid * 8 + i) * 8 + h]; v[i] = run; }
    float inc = run;
#pragma unroll
    for (int o = 1; o < 64; o <<= 1) { const float t = __shfl_up(inc, o); if (lane >= o) inc += t; }
    if (lane == 63) tot[wave] = inc;
    __syncthreads();
    float off = inc - run;
    for (int w = 0; w < wave; ++w) off += tot[w];
#pragma unroll
    for (int i = 0; i < 8; ++i) CB[(size_t)bh * SQ + tid * 8 + i] = -(v[i] + off) * 1.4426950408889634f;
    __syncthreads();
}

DI void hgrn_phase(const Args& A, LAS unsigned char* lds, int tid, int lane, int wave) {
    const int blk = blockIdx.x; if (blk >= 256) return;
    const int bh = blk >> 2, dq = blk & 3, b = bh >> 2, h = bh & 3;
    const _Float16* AQ = (const _Float16*)(A.ws + WS_PROJ); const _Float16* FF = AQ + PSTR; const _Float16* AI = AQ + 2 * PSTR;
    float* OA = (float*)(A.ws + WS_OA);
    LAS float* QL = (LAS float*)lds; LAS float* FL = QL + 64 * 128; LAS float* VL = FL + 64 * 128; LAS float* OL = VL + 64 * 32;
    const int dvl = lane >> 4, dkg = lane & 15, dvi = wave * 4 + dvl;
    const size_t row0 = (size_t)b * SQ;
    f32x2 S2[4];
#pragma unroll
    for (int i = 0; i < 4; ++i) S2[i] = (f32x2){0.f, 0.f};
    h8 pq[2], pf[2]; h4 pv;
    const int e0 = tid * 8;
    const int vt = tid >> 3, vo = (tid & 7) * 4;
#define HG_LOAD(c) do { _Pragma("unroll") for (int i = 0; i < 2; ++i) { const int e = e0 + i * 4096, t = e >> 7, dk = e & 127; const size_t g = (row0 + (size_t)(c) * 64 + t) * 512 + h * 128 + dk; pq[i] = *(const h8*)(AQ + g); pf[i] = *(const h8*)(FF + g); } \
        pv = *(const h4*)(AI + (row0 + (size_t)(c) * 64 + vt) * 512 + h * 128 + dq * 32 + vo); } while (0)
    HG_LOAD(0);
    for (int c = 0; c < 64; ++c) {
        __syncthreads();
#pragma unroll
        for (int i = 0; i < 2; ++i) { const int e = e0 + i * 4096;
            f32x4 a0, a1, b0, b1;
#pragma unroll
            for (int j = 0; j < 4; ++j) { a0[j] = (float)pq[i][j]; a1[j] = (float)pq[i][4 + j]; b0[j] = (float)pf[i][j]; b1[j] = (float)pf[i][4 + j]; }
            *(LAS f32x4*)(QL + e) = a0; *(LAS f32x4*)(QL + e + 4) = a1; *(LAS f32x4*)(FL + e) = b0; *(LAS f32x4*)(FL + e + 4) = b1; }
        { f32x4 vv; vv[0] = (float)pv[0]; vv[1] = (float)pv[1]; vv[2] = (float)pv[2]; vv[3] = (float)pv[3]; *(LAS f32x4*)(VL + vt * 32 + vo) = vv; }
        __syncthreads();
        if (c + 1 < 64) HG_LOAD(c + 1);
        f32x4 nf0 = *(const LAS f32x4*)(FL + dkg * 8), nf1 = *(const LAS f32x4*)(FL + dkg * 8 + 4), nq0 = *(const LAS f32x4*)(QL + dkg * 8), nq1 = *(const LAS f32x4*)(QL + dkg * 8 + 4);
        float nvv = VL[dvi];
#pragma unroll 4
        for (int t = 0; t < 64; ++t) {
            const f32x4 f0 = nf0, f1 = nf1, q0 = nq0, q1 = nq1; const float vv = nvv;
            { const int o = ((t + 1) & 63) * 128 + dkg * 8;
              nf0 = *(const LAS f32x4*)(FL + o); nf1 = *(const LAS f32x4*)(FL + o + 4); nq0 = *(const LAS f32x4*)(QL + o); nq1 = *(const LAS f32x4*)(QL + o + 4); nvv = VL[((t + 1) & 63) * 32 + dvi]; }
            const f32x2 v2 = {vv, vv};
            S2[0] = (f32x2){f0[0], f0[1]} * (S2[0] - v2) + v2; S2[1] = (f32x2){f0[2], f0[3]} * (S2[1] - v2) + v2;
            S2[2] = (f32x2){f1[0], f1[1]} * (S2[2] - v2) + v2; S2[3] = (f32x2){f1[2], f1[3]} * (S2[3] - v2) + v2;
            f32x2 op = S2[0] * (f32x2){q0[0], q0[1]} + S2[1] * (f32x2){q0[2], q0[3]}; op = op + (S2[2] * (f32x2){q1[0], q1[1]} + S2[3] * (f32x2){q1[2], q1[3]});
            const float o = red16(op.x + op.y);
            if (dkg == 0) OL[t * 32 + dvi] = o;
        }
        __syncthreads();
        { const f32x4 ov = *(const LAS f32x4*)(OL + vt * 32 + vo); *(f32x4*)(OA + (row0 + (size_t)c * 64 + vt) * 512 + h * 128 + dq * 32 + vo) = ov; }
    }
#undef HG_LOAD
    __syncthreads();
}

DI u16 f2bf(float f) { const unsigned u = __float_as_uint(f); return (u16)((u + 0x7fffu + ((u >> 16) & 1u)) >> 16); }
DI void hgrn_mfma_phase(const Args& A, LAS unsigned char* lds, int tid, int lane, int wave) {
    typedef short bfx8 __attribute__((ext_vector_type(8)));
    const int bh = blockIdx.x >> 1, half = blockIdx.x & 1, b = bh >> 2, h = bh & 3;
    const _Float16* AQ = (const _Float16*)(A.ws + WS_PROJ); const _Float16* FF = AQ + PSTR; const _Float16* AI = AQ + 2 * PSTR;
    float* OA = (float*)(A.ws + WS_OA);
    LAS _Float16* QH = (LAS _Float16*)lds; LAS _Float16* FH = QH + 64 * 128; LAS u16* AS = (LAS u16*)lds;
    LAS u16* Qt = (LAS u16*)(lds + 32768); LAS u16* Kt = Qt + 64 * 136; LAS u16* KhT = Kt + 64 * 136; LAS u16* VT = KhT + 128 * 72; LAS u16* ST = VT + 128 * 72;
    LAS float* EBL = (LAS float*)(ST + 128 * 136); LAS float* SEG = EBL + 128; LAS float* NS = SEG + 512;
    const size_t row0 = (size_t)b * SQ;
    const int l16 = lane & 15, lq = lane >> 4;
    const _Float16* AGp = (const _Float16*)(A.ws + WS_PROJ) + 3 * PSTR; u16* Y = (u16*)(A.ws + WS_XN);
    f32x4 gnv[4]; h4 pg[4];
#pragma unroll
    for (int j = 0; j < 4; ++j) gnv[j] = *(const f32x4*)(A.in[5] + h * 128 + 16 * ((wave & 1) * 4 + j) + 4 * lq);
    for (int i = tid; i < 128 * 136 / 2; i += 512) ((LAS unsigned*)ST)[i] = 0u;
    f32x4 Sacc[8];
#pragma unroll
    for (int j = 0; j < 8; ++j) Sacc[j] = (f32x4){0.f, 0.f, 0.f, 0.f};
    h8 pq[2], pf[2], pv[2];
    const int e0 = tid * 8;
    const int cd = tid & 127, tq = tid >> 7;
#define HG_LOAD(c) do { _Pragma("unroll") for (int i = 0; i < 2; ++i) { const int e = e0 + i * 4096, t = e >> 7, dk = e & 127; const size_t g = (row0 + (size_t)(c) * 64 + t) * 512 + h * 128 + dk; pq[i] = *(const h8*)(AQ + g); pf[i] = *(const h8*)(FF + g); pv[i] = *(const h8*)(AI + g); } } while (0)
    const int c_out = half ? 32 : 0, c_end = half ? 64 : 32; int cs = c_out;
    if (half) {
        float accd = 1.0f;
        while (cs > 0) {
            const int j = cs - 1;
#pragma unroll
            for (int i = 0; i < 2; ++i) { const int e = e0 + i * 4096, t = e >> 7, dk = e & 127; *(LAS h8*)(FH + e) = *(const h8*)(FF + (row0 + (size_t)j * 64 + t) * 512 + h * 128 + dk); }
            __syncthreads();
            float run = 1.0f;
#pragma unroll
            for (int i = 0; i < 16; ++i) run *= (float)FH[(16 * tq + i) * 128 + cd];
            SEG[tq * 128 + cd] = run;
            __syncthreads();
            accd *= (SEG[cd] * SEG[128 + cd]) * (SEG[256 + cd] * SEG[384 + cd]);
            float m = accd;
#pragma unroll
            for (int o_ = 1; o_ < 64; o_ <<= 1) m = fmaxf(m, __shfl_xor(m, o_));
            if (lane == 0) NS[wave] = m;
            __syncthreads();
            float mx = NS[0];
#pragma unroll
            for (int w_ = 1; w_ < 8; ++w_) mx = fmaxf(mx, NS[w_]);
            cs = j;
            __syncthreads();
            if (mx < 2.8e-14f) break;
        }
    }
    HG_LOAD(cs);
    for (int c = cs; c < c_end; ++c) {
        const bool emit = (c >= c_out);
#pragma unroll
        for (int i = 0; i < 2; ++i) { const int e = e0 + i * 4096, t = e >> 7, dv = e & 127; *(LAS h8*)(QH + e) = pq[i]; *(LAS h8*)(FH + e) = pf[i];
#pragma unroll
            for (int j = 0; j < 8; j += 2) { const unsigned vw = pk_bf16((float)pv[i][j], (float)pv[i][j + 1]); VT[(dv + j) * 72 + t] = (u16)vw; VT[(dv + j + 1) * 72 + t] = (u16)(vw >> 16); } }
        __syncthreads();
        if (c + 1 < c_end) HG_LOAD(c + 1);
#pragma unroll
        for (int j = 0; j < 4; ++j) pg[j] = *(const h4*)(AGp + (row0 + (size_t)c * 64 + 16 * (wave >> 1) + l16) * 512 + h * 128 + 16 * ((wave & 1) * 4 + j) + 4 * lq);
        float cs[16], kq[16]; float run = 1.0f;
#pragma unroll
        for (int i = 0; i < 16; ++i) { const float f = (float)FH[(16 * tq + i) * 128 + cd]; kq[i] = 1.0f - f; run *= f; cs[i] = run; }
        SEG[tq * 128 + cd] = run;
        __syncthreads();
        { const float s0 = SEG[cd], s1 = SEG[128 + cd], s2 = SEG[256 + cd], s3 = SEG[384 + cd];
          const float off = (tq > 0 ? s0 : 1.0f) * (tq > 1 ? s1 : 1.0f) * (tq > 2 ? s2 : 1.0f), ebl = (s0 * s1) * (s2 * s3);
          unsigned khw[8];
#pragma unroll
          for (int i = 0; i < 16; i += 2) { const int t = 16 * tq + i; const float q0 = (float)QH[t * 128 + cd], q1 = (float)QH[(t + 1) * 128 + cd];
              const float x0 = cs[i] * off, x1 = cs[i + 1] * off, k0 = kq[i] * __builtin_amdgcn_rcpf(x0), k1 = kq[i + 1] * __builtin_amdgcn_rcpf(x1);
              const unsigned qw = pk_bf16(q0 * x0, q1 * x1), kw = pk_bf16(k0, k1);
              Qt[t * 136 + cd] = (u16)qw; Qt[(t + 1) * 136 + cd] = (u16)(qw >> 16); Kt[t * 136 + cd] = (u16)kw; Kt[(t + 1) * 136 + cd] = (u16)(kw >> 16);
              khw[i >> 1] = pk_bf16(k0 * ebl, k1 * ebl); }
          if (tq == 0) EBL[cd] = ebl;
          *(LAS u32x4*)(KhT + cd * 72 + 16 * tq) = (u32x4){khw[0], khw[1], khw[2], khw[3]}; *(LAS u32x4*)(KhT + cd * 72 + 16 * tq + 8) = (u32x4){khw[4], khw[5], khw[6], khw[7]}; }
        __syncthreads();
        { const int tt = wave >> 1;
#pragma unroll
          for (int j = 0; j < 2; ++j) { const int st = (wave & 1) * 2 + j; f32x4 acc = (f32x4){0.f, 0.f, 0.f, 0.f};
              if (st <= tt) {
#pragma unroll
                  for (int kk = 0; kk < 4; ++kk) { const bfx8 X = *(const LAS bfx8*)(Kt + (16 * st + l16) * 136 + 32 * kk + 8 * lq), Y = *(const LAS bfx8*)(Qt + (16 * tt + l16) * 136 + 32 * kk + 8 * lq);
                      acc = __builtin_amdgcn_mfma_f32_16x16x32_bf16(X, Y, acc, 0, 0, 0); } }
              const int t = 16 * tt + l16, s = 16 * st + 4 * lq; u32x2 w;
              w.x = pk_bf16(s + 0 <= t ? acc[0] : 0.f, s + 1 <= t ? acc[1] : 0.f); w.y = pk_bf16(s + 2 <= t ? acc[2] : 0.f, s + 3 <= t ? acc[3] : 0.f);
              *(LAS u32x2*)(AS + t * 72 + s) = w; } }
        __syncthreads();
        f32x4 oacc[4];
        { const int tt = wave >> 1; bfx8 ya[2], yq[4];
#pragma unroll
          for (int kk = 0; kk < 2; ++kk) ya[kk] = *(const LAS bfx8*)(AS + (16 * tt + l16) * 72 + 32 * kk + 8 * lq);
#pragma unroll
          for (int kk = 0; kk < 4; ++kk) yq[kk] = *(const LAS bfx8*)(Qt + (16 * tt + l16) * 136 + 32 * kk + 8 * lq);
#pragma unroll
          for (int j = 0; j < 4; ++j) { const int vt = (wave & 1) * 4 + j; f32x4 acc = (f32x4){0.f, 0.f, 0.f, 0.f};
#pragma unroll
              for (int kk = 0; kk < 2; ++kk) acc = __builtin_amdgcn_mfma_f32_16x16x32_bf16(*(const LAS bfx8*)(VT + (16 * vt + l16) * 72 + 32 * kk + 8 * lq), ya[kk], acc, 0, 0, 0);
#pragma unroll
              for (int kk = 0; kk < 4; ++kk) acc = __builtin_amdgcn_mfma_f32_16x16x32_bf16(*(const LAS bfx8*)(ST + (16 * vt + l16) * 136 + 32 * kk + 8 * lq), yq[kk], acc, 0, 0, 0);
              oacc[j] = acc; }
          { float s_ = 0.f;
#pragma unroll
            for (int j = 0; j < 4; ++j) s_ += (oacc[j][0] * oacc[j][0] + oacc[j][1] * oacc[j][1]) + (oacc[j][2] * oacc[j][2] + oacc[j][3] * oacc[j][3]);
            s_ += __shfl_xor(s_, 16); s_ += __shfl_xor(s_, 32);
            if (lq == 0) NS[(16 * tt + l16) * 2 + (wave & 1)] = s_; }
          const bfx8 xv0 = *(const LAS bfx8*)(VT + (16 * wave + l16) * 72 + 8 * lq), xv1 = *(const LAS bfx8*)(VT + (16 * wave + l16) * 72 + 32 + 8 * lq);
#pragma unroll
          for (int dt = 0; dt < 8; ++dt) { const float dec = EBL[16 * dt + l16]; f32x4 sa = Sacc[dt] * dec;
              sa = __builtin_amdgcn_mfma_f32_16x16x32_bf16(xv0, *(const LAS bfx8*)(KhT + (16 * dt + l16) * 72 + 8 * lq), sa, 0, 0, 0);
              sa = __builtin_amdgcn_mfma_f32_16x16x32_bf16(xv1, *(const LAS bfx8*)(KhT + (16 * dt + l16) * 72 + 32 + 8 * lq), sa, 0, 0, 0);
              Sacc[dt] = sa; } }
        __syncthreads();
        { const int tt = wave >> 1; const float rstd = rsqrtf((NS[(16 * tt + l16) * 2] + NS[(16 * tt + l16) * 2 + 1]) * (1.0f / 128.0f) + 1e-6f);
          const size_t grow = row0 + (size_t)c * 64 + 16 * tt + l16;
          if (emit)
#pragma unroll
          for (int j = 0; j < 4; ++j) { const int vcol = h * 128 + 16 * ((wave & 1) * 4 + j) + 4 * lq; const h4 gt = pg[j];
              u32x2 w_; w_.x = pk_bf16(oacc[j][0] * rstd * gnv[j][0] * (float)gt[0], oacc[j][1] * rstd * gnv[j][1] * (float)gt[1]); w_.y = pk_bf16(oacc[j][2] * rstd * gnv[j][2] * (float)gt[2], oacc[j][3] * rstd * gnv[j][3] * (float)gt[3]);
              *(u32x2*)(Y + grow * 1024 + vcol) = w_; } }
#pragma unroll
        for (int dt = 0; dt < 8; ++dt)
#pragma unroll
            for (int r = 0; r < 4; r += 2) { const unsigned sw = pk_bf16(Sacc[dt][r], Sacc[dt][r + 1]); ST[(16 * wave + 4 * lq + r) * 136 + 16 * dt + l16] = (u16)sw; ST[(16 * wave + 4 * lq + r + 1) * 136 + 16 * dt + l16] = (u16)(sw >> 16); }
    }
#undef HG_LOAD
    __syncthreads();
}

DI void hgrn_norm_phase(const Args& A, int lane, int wave) {
    const float* OA = (const float*)(A.ws + WS_OA); const _Float16* AG = (const _Float16*)(A.ws + WS_PROJ) + 3 * PSTR; const float* gn = A.in[5];
    u16* Y = (u16*)(A.ws + WS_XN);
    const int gw = blockIdx.x * 8 + wave, NGW = gridDim.x * 8, c0 = lane * 8;
    const f32x4 g0 = *(const f32x4*)(gn + c0), g1 = *(const f32x4*)(gn + c0 + 4);
    for (int m = gw; m < TT; m += NGW) {
        f32x4 v0 = *(const f32x4*)(OA + (size_t)m * 512 + c0), v1 = *(const f32x4*)(OA + (size_t)m * 512 + c0 + 4);
        const h8 gg = *(const h8*)(AG + (size_t)m * 512 + c0);
        float s = (v0[0] * v0[0] + v0[1] * v0[1]) + (v0[2] * v0[2] + v0[3] * v0[3]) + (v1[0] * v1[0] + v1[1] * v1[1]) + (v1[2] * v1[2] + v1[3] * v1[3]);
        s = red16(s);
        const float rstd = rsqrtf(s * (1.0f / 128.0f) + 1e-6f);
#pragma unroll
        for (int j = 0; j < 4; ++j) { v0[j] = v0[j] * rstd * g0[j] * (float)gg[j]; v1[j] = v1[j] * rstd * g1[j] * (float)gg[4 + j]; }
        st8_bf16(Y + (size_t)m * 1024 + c0, v0, v1);
    }
}

DI void knorm_phase(const Args& A, int lane, int wave) {
    u16* BK = (u16*)(A.ws + WS_PROJ) + 5 * PSTR; const float* gk = A.in[8];
    const int gw = blockIdx.x * 8 + wave, NGW = gridDim.x * 8, c0 = lane * 8;
    const f32x4 g0 = *(const f32x4*)(gk + (c0 & 63)), g1 = *(const f32x4*)(gk + (c0 & 63) + 4);
    for (int m = gw; m < TT; m += NGW) {
        const u32x4 w = *(const u32x4*)(BK + (size_t)m * 512 + c0);
        f32x4 v0, v1;
        v0[0] = __uint_as_float(w.x << 16); v0[1] = __uint_as_float(w.x & 0xffff0000u); v0[2] = __uint_as_float(w.y << 16); v0[3] = __uint_as_float(w.y & 0xffff0000u);
        v1[0] = __uint_as_float(w.z << 16); v1[1] = __uint_as_float(w.z & 0xffff0000u); v1[2] = __uint_as_float(w.w << 16); v1[3] = __uint_as_float(w.w & 0xffff0000u);
        float s = (v0[0] * v0[0] + v0[1] * v0[1]) + (v0[2] * v0[2] + v0[3] * v0[3]) + (v1[0] * v1[0] + v1[1] * v1[1]) + (v1[2] * v1[2] + v1[3] * v1[3]);
        s = red8(s);
        const float rstd = rsqrtf(s * (1.0f / 64.0f) + 1e-6f);
        v0 = v0 * rstd * g0; v1 = v1 * rstd * g1;
        st8_bf16(BK + (size_t)m * 512 + c0, v0, v1);
    }
}

DI void norm1_phase(const Args& A, int lane, int wave) {
    const u16* hsrc = (const u16*)A.out; const float* g = A.in[1] + 1024; const float* mu = A.in[10]; u16* XN = (u16*)(A.ws + WS_XN); u16* MX = (u16*)(A.ws + WS_PROJ);
    const int gw = blockIdx.x * 8 + wave, NGW = gridDim.x * 8;
    if (gw < NB) { u32x2* o8 = (u32x2*)(XN + (size_t)gw * 4097 * 1024) + lane;
#pragma unroll
        for (int j = 0; j < 4; ++j) o8[64 * j] = (u32x2){0u, 0u}; }
    f32x4 gv[4], mu0[4], mu2[4], mu3[4];
#pragma unroll
    for (int j = 0; j < 4; ++j) { const int c = 4 * lane + 256 * j; gv[j] = *(const f32x4*)(g + c); mu0[j] = *(const f32x4*)(mu + c); mu2[j] = *(const f32x4*)(mu + 2 * 1024 + c); mu3[j] = *(const f32x4*)(mu + 3 * 1024 + c); }
    asm volatile("" ::: "memory");
    const int rows_per = TT / NGW;
    const int m0 = gw * rows_per;
    f32x4 prev[4];
    if ((m0 & 4095) == 0) {
#pragma unroll
        for (int j = 0; j < 4; ++j) prev[j] = (f32x4){0.f, 0.f, 0.f, 0.f};
    } else {
        const u32x2* xr = (const u32x2*)(hsrc + (size_t)(m0 - 1) * 1024) + lane; float s = 0.f;
#pragma unroll
        for (int j = 0; j < 4; ++j) { const u32x2 w_ = xr[64 * j]; prev[j] = (f32x4){__uint_as_float(w_.x << 16), __uint_as_float(w_.x & 0xffff0000u), __uint_as_float(w_.y << 16), __uint_as_float(w_.y & 0xffff0000u)}; s += (prev[j][0] * prev[j][0] + prev[j][1] * prev[j][1]) + (prev[j][2] * prev[j][2] + prev[j][3] * prev[j][3]); }
        const float rstd = rsqrtf(wave_sum(s) * (1.0f / 1024.0f) + 1e-6f);
#pragma unroll
        for (int j = 0; j < 4; ++j) prev[j] = prev[j] * rstd * gv[j];
    }
    for (int m = m0; m < m0 + rows_per; ++m) {
        const u32x2* xr = (const u32x2*)(hsrc + (size_t)m * 1024) + lane;
        f32x4 v[4]; float s = 0.f;
#pragma unroll
        for (int j = 0; j < 4; ++j) { const u32x2 w_ = xr[64 * j]; v[j] = (f32x4){__uint_as_float(w_.x << 16), __uint_as_float(w_.x & 0xffff0000u), __uint_as_float(w_.y << 16), __uint_as_float(w_.y & 0xffff0000u)}; s += (v[j][0] * v[j][0] + v[j][1] * v[j][1]) + (v[j][2] * v[j][2] + v[j][3] * v[j][3]); }
        const float rstd = rsqrtf(wave_sum(s) * (1.0f / 1024.0f) + 1e-6f);
        if ((m & 4095) == 0) {
#pragma unroll
            for (int j = 0; j < 4; ++j) prev[j] = (f32x4){0.f, 0.f, 0.f, 0.f};
        }
        const size_t prow = (size_t)(m >> 12) * 4097 + 1 + (m & 4095);
        u32x2* o8 = (u32x2*)(XN + prow * 1024) + lane;
        u32x2* o0 = (u32x2*)(MX + (size_t)m * 1024) + lane; u32x2* o1 = (u32x2*)(MX + RSTR + (size_t)m * 1024) + lane; u32x2* o2 = (u32x2*)(MX + 2 * RSTR + (size_t)m * 1024) + lane;
#pragma unroll
        for (int j = 0; j < 4; ++j) {
            v[j] = v[j] * rstd * gv[j];
            const f32x4 xx = prev[j] - v[j];
            u32x2 w; w.x = pk_bf16(v[j][0], v[j][1]); w.y = pk_bf16(v[j][2], v[j][3]); o8[64 * j] = w;
            f32x4 t = v[j] + xx * mu0[j];            w.x = pk_bf16(t[0], t[1]); w.y = pk_bf16(t[2], t[3]); o0[64 * j] = w;
            t = v[j] + xx * mu2[j];       w.x = pk_bf16(t[0], t[1]); w.y = pk_bf16(t[2], t[3]); o1[64 * j] = w;
            t = v[j] + xx * mu3[j];       w.x = pk_bf16(t[0], t[1]); w.y = pk_bf16(t[2], t[3]); o2[64 * j] = w;
            prev[j] = v[j];
        }
    }
}

DI void wkv_phase(const Args& A, LAS unsigned char* lds, int tid, int lane, int wave) {
    typedef short bfx8 __attribute__((ext_vector_type(8)));
    const int blk = blockIdx.x; if (blk >= 256) return;
    const int b = blk >> 4, hh = blk & 15;
    const _Float16* R = (const _Float16*)(A.ws + WS_RKV); const _Float16* KR = R + RSTR; const _Float16* V = R + 2 * RSTR;
    const u16* LH = (const u16*)(A.ws + WS_LH); const u16* W2 = (const u16*)(A.ws + WS_W2);
    u16* Z = (u16*)(A.ws + WS_XN);
    constexpr int CH = 32;
    LAS float* Lw = (LAS float*)lds; LAS float* La = Lw + CH * 64; LAS float* Lb = La + CH * 64; LAS float* Lk = Lb + CH * 64; LAS float* Lr = Lk + CH * 64; LAS float* Lv = Lr + CH * 64;
    LAS float* Ly = Lv + CH * 64; LAS float* Lbon = Ly + CH * 256;
    LAS float* Lga = Lbon + 64; LAS float* Lgg = Lga + CH * 64;
    const int pt = tid >> 4, pi = (tid & 15) * 4;
    const int ch = hh * 64 + pi;
    const f32x4 c_kk = *(const f32x4*)(A.in[20] + ch), c_ka = *(const f32x4*)(A.in[21] + ch), c_rk = *(const f32x4*)(A.in[22] + ch), c_lg = *(const f32x4*)(A.in[23] + ch), c_lb = *(const f32x4*)(A.in[24] + ch);
    const int v0 = wave * 8 + (lane >> 4) * 2, k0 = (lane & 15) * 4;
    const size_t row0 = (size_t)b * SQ;
    const int l16 = lane & 15, lq = lane >> 4, ct = wave >> 1, tt = wave & 1;
    bfx8 xw[2], xa[2], xg[4];
    { const u16* wp = W2 + (size_t)(hh * 64 + 16 * ct + l16) * 128 + 8 * lq;
#pragma unroll
      for (int kk = 0; kk < 2; ++kk) { xw[kk] = *(const bfx8*)(wp + 32 * kk); xa[kk] = *(const bfx8*)(wp + (size_t)1024 * 128 + 32 * kk); }
#pragma unroll
      for (int kk = 0; kk < 4; ++kk) xg[kk] = *(const bfx8*)(wp + (size_t)2048 * 128 + 32 * kk); }
    const int mch = 16 * ct + l16;
    const float bw0 = A.in[12][hh * 64 + mch], ba0 = A.in[15][hh * 64 + mch];
    f32x2 S0a = {0.f, 0.f}, S0b = {0.f, 0.f}, S1a = {0.f, 0.f}, S1b = {0.f, 0.f};
    h4 xr, xk, xv; f32x4 g_cur; bfx8 yl[8];
#define WK_LOAD(c) do { const size_t g = (row0 + (size_t)(c) * CH + pt) * 1024 + ch; xr = *(const h4*)(R + g); xk = *(const h4*)(KR + g); xv = *(const h4*)(V + g); \
        const u16* lp_ = LH + (row0 + (size_t)(c) * CH + 16 * tt + l16) * 256 + 8 * lq; \
        _Pragma("unroll") for (int kk = 0; kk < 2; ++kk) { yl[kk] = *(const bfx8*)(lp_ + 32 * kk); yl[2 + kk] = *(const bfx8*)(lp_ + 64 + 32 * kk); } \
        _Pragma("unroll") for (int kk = 0; kk < 4; ++kk) yl[4 + kk] = *(const bfx8*)(lp_ + 128 + 32 * kk); } while (0)
#define WK_LORA() do { f32x4 dw = {0.f, 0.f, 0.f, 0.f}, da = {0.f, 0.f, 0.f, 0.f}, dg = {0.f, 0.f, 0.f, 0.f}; \
        _Pragma("unroll") for (int kk = 0; kk < 2; ++kk) { dw = __builtin_amdgcn_mfma_f32_16x16x32_bf16(yl[kk], xw[kk], dw, 0, 0, 0); da = __builtin_amdgcn_mfma_f32_16x16x32_bf16(yl[2 + kk], xa[kk], da, 0, 0, 0); } \
        _Pragma("unroll") for (int kk = 0; kk < 4; ++kk) dg = __builtin_amdgcn_mfma_f32_16x16x32_bf16(yl[4 + kk], xg[kk], dg, 0, 0, 0); \
        _Pragma("unroll") for (int j = 0; j < 4; ++j) { dw[j] = __expf(-0.60653066f * sigm(dw[j] + bw0)); da[j] = sigm(da[j] + ba0); \
            const int o_ = (16 * tt + 4 * lq + j) * 64 + mch; Lw[o_] = dw[j]; Lga[o_] = da[j]; Lgg[o_] = dg[j]; } } while (0)
    WK_LOAD(0);
    WK_LORA();
    constexpr int NCH = SQ / CH;
    for (int c = 0; c < NCH; ++c) {
        __syncthreads();
        {
            f32x4 r4, k4, v4, kk, kx, an, bn;
            const f32x4 a4 = *(const LAS f32x4*)(Lga + pt * 64 + pi); g_cur = *(const LAS f32x4*)(Lgg + pt * 64 + pi);
#pragma unroll
            for (int j = 0; j < 4; ++j) { r4[j] = (float)xr[j]; k4[j] = (float)xk[j]; v4[j] = (float)xv[j]; }
            kk = k4 * c_kk;
            float ssq = (kk[0] * kk[0] + kk[1] * kk[1]) + (kk[2] * kk[2] + kk[3] * kk[3]); ssq = red16(ssq);
            const float inv = rsqrtf(fmaxf(ssq, 1e-24f));
            float bon = 0.f;
#pragma unroll
            for (int j = 0; j < 4; ++j) { const float kn = kk[j] * inv; kx[j] = k4[j] * (1.0f + (a4[j] - 1.0f) * c_ka[j]); an[j] = -kn; bn[j] = kn * a4[j]; bon += r4[j] * kx[j] * c_rk[j]; }
            bon = red16(bon);
            const int o = pt * 64 + pi;
            *(LAS f32x4*)(La + o) = an; *(LAS f32x4*)(Lb + o) = bn; *(LAS f32x4*)(Lk + o) = kx; *(LAS f32x4*)(Lr + o) = r4; *(LAS f32x4*)(Lv + o) = v4;
            if ((tid & 15) == 0) Lbon[pt] = bon;
        }
        __syncthreads();
        if (c + 1 < NCH) WK_LOAD(c + 1);
        f32x4 na4 = *(const LAS f32x4*)(La + k0), nw4 = *(const LAS f32x4*)(Lw + k0), nb4 = *(const LAS f32x4*)(Lb + k0), nk4 = *(const LAS f32x4*)(Lk + k0), nr4 = *(const LAS f32x4*)(Lr + k0);
        f32x2 nvv = *(const LAS f32x2*)(Lv + v0);
#pragma unroll 4
        for (int t = 0; t < CH; ++t) {
            const f32x4 a4 = na4, w4 = nw4, b4 = nb4, k4 = nk4, r4 = nr4; const f32x2 vv = nvv;
            { const int o = (t + 1) * 64 + k0;
              na4 = *(const LAS f32x4*)(La + o); nw4 = *(const LAS f32x4*)(Lw + o); nb4 = *(const LAS f32x4*)(Lb + o); nk4 = *(const LAS f32x4*)(Lk + o); nr4 = *(const LAS f32x4*)(Lr + o);
              nvv = *(const LAS f32x2*)(Lv + (t + 1) * 64 + v0); }
            const f32x2 alo = {a4[0], a4[1]}, ahi = {a4[2], a4[3]}, wlo = {w4[0], w4[1]}, whi = {w4[2], w4[3]}, blo = {b4[0], b4[1]}, bhi = {b4[2], b4[3]}, klo = {k4[0], k4[1]}, khi = {k4[2], k4[3]}, rlo = {r4[0], r4[1]}, rhi = {r4[2], r4[3]};
            f32x2 p0 = S0a * alo + S0b * ahi, p1 = S1a * alo + S1b * ahi;
            const float sa0 = red16(p0.x + p0.y), sa1 = red16(p1.x + p1.y);
            const f32x2 sa0v = {sa0, sa0}, sa1v = {sa1, sa1}, v0v = {vv.x, vv.x}, v1v = {vv.y, vv.y};
            S0a = S0a * wlo + (sa0v * blo + v0v * klo); S0b = S0b * whi + (sa0v * bhi + v0v * khi);
            S1a = S1a * wlo + (sa1v * blo + v1v * klo); S1b = S1b * whi + (sa1v * bhi + v1v * khi);
            p0 = S0a * rlo + S0b * rhi; p1 = S1a * rlo + S1b * rhi;
            float y0 = p0.x + p0.y, y1 = p1.x + p1.y;
            y0 += dpp_f<0xB1>(y0); y1 += dpp_f<0xB1>(y1); y0 += dpp_f<0x4E>(y0); y1 += dpp_f<0x4E>(y1);
            if ((lane & 3) == 0) *(LAS f32x2*)(Ly + t * 256 + ((lane & 15) >> 2) * 64 + v0) = (f32x2){y0, y1};
        }
        __syncthreads();
        {
            const int o = pt * 64 + pi;
            const f32x4 y4 = (*(const LAS f32x4*)(Ly + pt * 256 + pi) + *(const LAS f32x4*)(Ly + pt * 256 + 64 + pi)) + (*(const LAS f32x4*)(Ly + pt * 256 + 128 + pi) + *(const LAS f32x4*)(Ly + pt * 256 + 192 + pi)), v4 = *(const LAS f32x4*)(Lv + o); const float bon = Lbon[pt];
            const float mean = red16((y4[0] + y4[1]) + (y4[2] + y4[3])) * (1.0f / 64.0f);
            const f32x4 d = y4 - mean;
            const float var = red16((d[0] * d[0] + d[1] * d[1]) + (d[2] * d[2] + d[3] * d[3])) * (1.0f / 64.0f);
            const float rs = rsqrtf(var + 64e-5f);
            float z[4];
#pragma unroll
            for (int j = 0; j < 4; ++j) z[j] = (d[j] * rs * c_lg[j] + c_lb[j] + bon * v4[j]) * g_cur[j];
            u32x2 w; w.x = pk_bf16(z[0], z[1]); w.y = pk_bf16(z[2], z[3]);
            *(u32x2*)(Z + (row0 + (size_t)c * CH + pt) * 1024 + ch) = w;
        }
        if (c + 1 < NCH) WK_LORA();
    }
#undef WK_LOAD
#undef WK_LORA
}

#define XB_TMO      128
#define XB_XCNT(j)  (256  + 64 * (j))
#define XB_XSUB(j)  (1280 + 64 * (j))
#define XB_XGEN(j)  (2304 + 64 * (j))
#define XB_TOP      3328
#define XB_TOPGEN   3392
#define XCD_BAR_WORDS 3456
#define XB_SPIN_CAP (1u << 18)

__device__ __forceinline__ unsigned xb_ld(unsigned* p)              { return __hip_atomic_load(p, __ATOMIC_RELAXED, __HIP_MEMORY_SCOPE_AGENT); }
__device__ __forceinline__ unsigned xb_add(unsigned* p, unsigned v) { return __hip_atomic_fetch_add(p, v, __ATOMIC_RELAXED, __HIP_MEMORY_SCOPE_AGENT); }
__device__ __forceinline__ unsigned xb_xcc_id() { return (unsigned)__builtin_amdgcn_s_getreg((3 << 11) | 20) & 0xFu; }
#define XB_SPIN(cond, bar) do { unsigned _sp = 0; while (cond) { __builtin_amdgcn_s_sleep(1); \
    if ((++_sp & 255u) == 0u) { if (xb_ld(&(bar)[XB_TMO])) break; if (_sp > XB_SPIN_CAP) { atomicAdd(&(bar)[XB_TMO], 1u); break; } } } } while (0)

struct XcdBarrier {
    unsigned* bar; unsigned x;
    volatile LAS unsigned* st;
};

__device__ __forceinline__ XcdBarrier xcd_barrier_post(unsigned* bar, volatile LAS unsigned* st) {
    XcdBarrier b; b.bar = bar; b.x = xb_xcc_id(); b.st = st;
    if (threadIdx.x == 0) (void)xb_add(&bar[XB_XCNT(b.x)], 1u);
    return b;
}
__device__ __forceinline__ void xcd_barrier_complete(unsigned* bar, unsigned x, unsigned& nloc, unsigned& nx) {
    const unsigned G = gridDim.x * gridDim.y * gridDim.z;
    unsigned sum, cnt, mine, sp = 0u;
    for (;;) {
        sum = 0u; cnt = 0u; mine = 0u;
#pragma unroll
        for (unsigned j = 0; j < 16; ++j) { const unsigned c = xb_ld(&bar[XB_XCNT(j)]); sum += c; cnt += (c > 0u) ? 1u : 0u; mine = (j == x) ? c : mine; }
        if (sum == G) break;
        __builtin_amdgcn_s_sleep(1);
        if ((++sp & 255u) == 0u) { if (xb_ld(&bar[XB_TMO])) break; if (sp > XB_SPIN_CAP) { atomicAdd(&bar[XB_TMO], 1u); break; } }
    }
    nloc = mine > 0u ? mine : 1u; nx = cnt > 0u ? cnt : 1u;
}

__device__ __forceinline__ void xcd_barrier(const XcdBarrier& b) {
    asm volatile("s_waitcnt vmcnt(0)" ::: "memory");
    __syncthreads();
    if (threadIdx.x == 0) {
        unsigned* bar = b.bar;
        __builtin_amdgcn_s_waitcnt(0);
        unsigned nloc = b.st[0], nx = b.st[1];
        if (nloc == 0u) { xcd_barrier_complete(bar, b.x, nloc, nx); b.st[0] = nloc; b.st[1] = nx; }
        const unsigned old = xb_add(&bar[XB_XSUB(b.x)], 1u);
        const unsigned gen = old / nloc;
        if (old + 1u == (gen + 1u) * nloc) {
            __builtin_amdgcn_fence(__ATOMIC_RELEASE, "agent");
            asm volatile("s_waitcnt vmcnt(0)" ::: "memory");
            const unsigned og = xb_add(&bar[XB_TOP], 1u);
            const unsigned tg = og / nx;
            if (og + 1u == (tg + 1u) * nx) xb_add(&bar[XB_TOPGEN], 1u);
            else XB_SPIN(xb_ld(&bar[XB_TOPGEN]) == tg, bar);
            __builtin_amdgcn_fence(__ATOMIC_ACQUIRE, "agent");
            xb_add(&bar[XB_XGEN(b.x)], 1u);
            asm volatile("s_waitcnt vmcnt(0)" ::: "memory");
        } else {
            XB_SPIN(xb_ld(&bar[XB_XGEN(b.x)]) == gen, bar);
            __builtin_amdgcn_fence(__ATOMIC_ACQUIRE, "agent");
            asm volatile("s_waitcnt vmcnt(0)" ::: "memory");
        }
    }
    __syncthreads();
}

struct RstdOrder : pg8::StaticOrder {
    const float* SS; LAS float* rs; mutable int k;
    DI void a_ready(const pg8::Unit& u) const {
        const int tid = threadIdx.x;
        if (tid < 256) { const float* p = SS + (size_t)(u.pm * 256 + tid) * 16;
            const f32x4 q0 = *(const f32x4*)p, q1 = *(const f32x4*)(p + 4), q2 = *(const f32x4*)(p + 8), q3 = *(const f32x4*)(p + 12); const f32x4 qs = (q0 + q1) + (q2 + q3);
            rs[(k & 1) * 256 + tid] = rsqrtf(((qs[0] + qs[1]) + (qs[2] + qs[3])) * (1.0f / 1024.0f) + 1e-6f); }
        ++k;
    }
};
DI void run_gemm_up(LAS unsigned char* lds, const pg8::bf16_t* Amat, const pg8::bf16_t* Bt, const float* SS, u16* HID) {
    pg8::Gemm g{Amat, Bt, TT, 4096, 1024, 1024, 0}; RstdOrder S; S.init(TT, 4096, (int)gridDim.x, (int)blockIdx.x); S.SS = SS; S.rs = (LAS float*)(lds + 131072); S.k = 0;
    Epi<2> E{EpiArgs{HID, nullptr, nullptr, nullptr, nullptr, nullptr}}; E.rs = (const LAS float*)(lds + 131072); E.ucnt = 0;
    pg8::gemm_phase<Epi<2>, RstdOrder, true, true>(lds, g, S, E);
}
template <int MODE> DI void run_gemm(LAS unsigned char* lds, const pg8::bf16_t* Amat, const pg8::bf16_t* Bt, int N, int K, int lda, int amode, const EpiArgs& ea, int rev = 0) {
    pg8::Gemm g{Amat, Bt, TT, N, K, lda, amode}; pg8::StaticOrder S; S.init(TT, N, (int)gridDim.x, (int)blockIdx.x); S.rev = rev;
    Epi<MODE> E{ea}; E.rs = (const LAS float*)(lds + 133120);
    pg8::gemm_phase<Epi<MODE>, pg8::StaticOrder, true, true>(lds, g, S, E);
}

__global__ void __launch_bounds__(512, 2) mega_fwd(Args A) {
    extern __shared__ __attribute__((aligned(16))) unsigned char lds_raw[];
    LAS unsigned char* lds = (LAS unsigned char*)lds_raw;
    cg::grid_group grid = cg::this_grid();
    unsigned char* ws = A.ws;
    volatile LAS unsigned* bst = (volatile LAS unsigned*)(lds + LDS_TOTAL - 64);
    if (threadIdx.x < 2) bst[threadIdx.x] = 0u;
    __syncthreads();
    const XcdBarrier xbar = xcd_barrier_post((unsigned*)(ws + WS_BAR), bst);
#define GSYNC() xcd_barrier(xbar)
#define TIDS int tid = threadIdx.x; asm volatile("" : "+v"(tid) :: "memory"); const int lane = tid & 63, wave = __builtin_amdgcn_readfirstlane(tid >> 6); (void)lane; (void)wave;
    typedef pg8::bf16_t bt;
    { TIDS p0_prologue(A, lds, tid, lane, wave); }
    GSYNC();
    if (A.ws == nullptr) grid.sync();
    { TIDS if (blockIdx.x < 128) fox_cumsum(A, lds, (int)blockIdx.x, tid, lane, wave); }
    { EpiArgs ea{(u16*)(ws + WS_PROJ), nullptr, (const float*)(ws + WS_LB), A.in[8], nullptr, (float*)(ws + WS_SSK)};
      run_gemm<0>(lds, (const bt*)(ws + WS_XN), (const bt*)(ws + WS_WIN), 4096, 1024, 1024, 0, ea); }
    GSYNC();
    {
        const attn_body::bf16* PB = (const attn_body::bf16*)(ws + WS_PROJ);
        const attn_body::AttnTensors AT{PB + 4 * PSTR, PB + 5 * PSTR, PB + 6 * PSTR, (attn_body::bf16*)(ws + WS_XN) + 512, (const float*)(ws + WS_SSK), (const float*)(ws + WS_CB), A.in[7], A.in[8], (const _Float16*)(ws + WS_PROJ) + 7 * PSTR};
        const attn_body::StaticOrder S((int)gridDim.x, (int)blockIdx.x);
        if (blockIdx.x < 128) { TIDS hgrn_mfma_phase(A, lds, tid, lane, wave); }
        __syncthreads();
        attn_body::attn_phase<attn_body::StaticOrder>((char*)lds_raw, AT, S);
    }
    GSYNC();
    { EpiArgs ea{(u16*)(ws + WS_HB), nullptr, A.in[0], nullptr, nullptr, (float*)(ws + WS_SS)};
      run_gemm<1>(lds, (const bt*)(ws + WS_XN), (const bt*)(ws + WS_WOUT), 1024, 1024, 1024, 0, ea); }
    GSYNC();
    run_gemm_up(lds, (const bt*)(ws + WS_HB), (const bt*)(ws + WS_WUP0), (const float*)(ws + WS_SS), (u16*)(ws + WS_PROJ));
    GSYNC();
    { EpiArgs ea{(u16*)A.out, (u16*)(ws + WS_HB), nullptr, nullptr, nullptr, nullptr};
      run_gemm<1>(lds, (const bt*)(ws + WS_PROJ), (const bt*)(ws + WS_WD0), 1024, 4096, 4096, 0, ea, 1); }
    GSYNC();
    { TIDS norm1_phase(A, lane, wave); }
    GSYNC();
    { EpiArgs ea{(u16*)(ws + WS_RKV), (u16*)(ws + WS_LH), nullptr, nullptr, nullptr, nullptr};
      run_gemm<3>(lds, (const bt*)(ws + WS_PROJ), (const bt*)(ws + WS_WBIG), 3072, 1024, 1024, 3, ea);
      run_gemm<5>(lds, (const bt*)(ws + WS_XN), (const bt*)(ws + WS_WLORA), 256, 2048, 1024, 1, ea); }
    GSYNC();
    { TIDS wkv_phase(A, lds, tid, lane, wave); }
    GSYNC();
    { EpiArgs ea{(u16*)(ws + WS_HB), (u16*)A.out, nullptr, nullptr, nullptr, (float*)(ws + WS_SS)};
      run_gemm<1>(lds, (const bt*)(ws + WS_XN), (const bt*)(ws + WS_WO), 1024, 1024, 1024, 0, ea); }
    GSYNC();
    run_gemm_up(lds, (const bt*)(ws + WS_HB), (const bt*)(ws + WS_WUP1), (const float*)(ws + WS_SS), (u16*)(ws + WS_PROJ));
    GSYNC();
    { EpiArgs ea{nullptr, (u16*)(ws + WS_HB), nullptr, nullptr, A.out, nullptr};
      run_gemm<1>(lds, (const bt*)(ws + WS_PROJ), (const bt*)(ws + WS_WD1), 1024, 4096, 4096, 0, ea, 1); }
}

extern "C" void kernel_launch(void* const* d_in, const int* in_sizes, int n_in, void* d_out, int out_size, void* d_ws, size_t ws_size, hipStream_t stream) {
    static int ready = 0;
    if (!ready) {
        if (n_in != 28 || ws_size < WS_END) { fprintf(stderr, "kernel_launch: unexpected n_in %d / ws_size %zu\n", n_in, ws_size); ready = -1; return; }
        if (hipFuncSetAttribute((const void*)mega_fwd, hipFuncAttributeMaxDynamicSharedMemorySize, LDS_TOTAL) != hipSuccess) { fprintf(stderr, "kernel_launch: hipFuncSetAttribute failed\n"); ready = -1; return; }
        int per_cu = 0; (void)hipOccupancyMaxActiveBlocksPerMultiprocessor(&per_cu, (const void*)mega_fwd, 512, LDS_TOTAL); (void)hipGetLastError();
        if (per_cu < 1) fprintf(stderr, "kernel_launch: occupancy query says %d blocks/CU\n", per_cu);
        ready = 1;
    }
    if (ready < 0) return;
    if (hipMemsetAsync((char*)d_ws + WS_BAR, 0, BAR_BYTES, stream) != hipSuccess) { fprintf(stderr, "kernel_launch: memset failed\n"); return; }
    Args a{};
    for (int i = 0; i < 28; ++i) a.in[i] = (const float*)d_in[i];
    a.out = (float*)d_out; a.ws = (unsigned char*)d_ws;
    void* args[] = {&a};
    hipError_t e = hipLaunchCooperativeKernel((const void*)mega_fwd, dim3(256), dim3(512), args, LDS_TOTAL, stream);
    if (e != hipSuccess) fprintf(stderr, "cooperative launch failed: %s\n", hipGetErrorString(e));
}
```
